# Optimizing an MI355X kernel written in HIP

```python
import math
import jax
import jax.numpy as jnp
from jax import lax
import numpy as np

D_MODEL = 1024
BATCH = 8
SEQ = 2048
DEPTH = 2
DEC_BATCH = 128
DEC_SEQ = 4
PAST_LEN = 16384
PAGE_SIZE = 128

MIX_WIDTH = D_MODEL
N_MIXERS = 4
GROUP_WIDTH = MIX_WIDTH // N_MIXERS
HEAD_DIM = 64
N_HEADS = GROUP_WIDTH // HEAD_DIM
CONV_WIDTH = 4
GDN_CONV_CH = 3 * GROUP_WIDTH
RET_THETA = 10000.0
SSD_STATE = 128
SSD_GROUPS = 2
SSD_CONV_CH = GROUP_WIDTH + 2 * SSD_GROUPS * SSD_STATE
D_FF = 4 * D_MODEL
CHUNK = 64
CHUNK_VEC = 16
EPS = 1e-6
SPLIT_SIZES = (
    GROUP_WIDTH, GROUP_WIDTH, GROUP_WIDTH, GROUP_WIDTH,
    GDN_CONV_CH, GROUP_WIDTH, N_HEADS, N_HEADS,
    GROUP_WIDTH, GROUP_WIDTH, GROUP_WIDTH, GROUP_WIDTH,
    GROUP_WIDTH, SSD_CONV_CH, N_HEADS,
)
P_TOTAL = sum(SPLIT_SIZES)

kernel_name = 'hymba_quad_linear_hybrid_step'


def _rms(x):
    return x * lax.rsqrt(jnp.mean(x * x, axis=-1, keepdims=True) + EPS)


def _l2norm(x):
    return x * lax.rsqrt(jnp.sum(x * x, axis=-1, keepdims=True) + EPS)


def _heads(t):
    return t.reshape(t.shape[:-1] + (N_HEADS, t.shape[-1] // N_HEADS))


def _to_chunks(t, c):
    return t.reshape((t.shape[0], t.shape[1] // c, c) + t.shape[2:])


def _causal_conv(x, buf, w):
    seq_len = x.shape[1]
    xe = jnp.concatenate([buf.astype(jnp.float32), x], axis=1)
    y = xe[:, 0:seq_len] * w[0]
    for j in range(1, CONV_WIDTH):
        y = y + xe[:, j:j + seq_len] * w[j]
    return y, xe[:, seq_len:]


def _rotary(x, pos):
    half = HEAD_DIM // 2
    inv_freq = RET_THETA ** (-jnp.arange(half, dtype=jnp.float32) / half)
    ang = pos.astype(jnp.float32)[:, None] * inv_freq[None, :]
    cos = jnp.cos(ang)[None, :, None, :]
    sin = jnp.sin(ang)[None, :, None, :]
    x1, x2 = x[..., :half], x[..., half:]
    return jnp.concatenate([x1 * cos - x2 * sin, x1 * sin + x2 * cos], axis=-1)


def _chunk_scalar_decay(q, k, v, log_a, s0):
    bsz, seq_len = q.shape[:2]
    c = math.gcd(seq_len, CHUNK)
    q, k, v, log_a = (_to_chunks(t, c) for t in (q, k, v, log_a))
    g = jnp.cumsum(log_a, axis=2)
    g_last = g[:, :, -1]
    causal = jnp.tril(jnp.ones((c, c), dtype=bool))
    diff = g[:, :, :, None, :] - g[:, :, None, :, :]
    decay = jnp.exp(jnp.where(causal[:, :, None], diff, -jnp.inf))
    scores = jnp.einsum('bnihk,bnjhk->bnijh', q, k) * decay
    o_intra = jnp.einsum('bnijh,bnjhv->bnihv', scores, v)
    k_end = k * jnp.exp(g_last[:, :, None] - g)[..., None]
    ds = jnp.einsum('bnjhk,bnjhv->bnhkv', k_end, v)
    a_chunk = jnp.exp(g_last)

    def step(s, inp):
        a_c, ds_c = inp
        return a_c[..., None, None] * s + ds_c, s

    s_fin, s_start = lax.scan(step, s0, (jnp.moveaxis(a_chunk, 1, 0), jnp.moveaxis(ds, 1, 0)))
    s_start = jnp.moveaxis(s_start, 0, 1)
    o_inter = jnp.einsum('bnihk,bnhkv->bnihv', q * jnp.exp(g)[..., None], s_start)
    return (o_intra + o_inter).reshape(bsz, seq_len, q.shape[3], v.shape[-1]), s_fin


def _chunk_vector_decay(q, k, v, log_f, s0):
    bsz, seq_len = q.shape[:2]
    c = math.gcd(seq_len, CHUNK_VEC)
    q, k, v, log_f = (_to_chunks(t, c) for t in (q, k, v, log_f))
    g = jnp.cumsum(log_f, axis=2)
    g_last = g[:, :, -1]
    causal = jnp.tril(jnp.ones((c, c), dtype=bool))
    diff = g[:, :, :, None] - g[:, :, None]
    decay = jnp.exp(jnp.where(causal[:, :, None, None], diff, -jnp.inf))
    scores = jnp.einsum('bnihk,bnjhk,bnijhk->bnijh', q, k, decay)
    o_intra = jnp.einsum('bnijh,bnjhv->bnihv', scores, v)
    k_end = k * jnp.exp(g_last[:, :, None] - g)
    ds = jnp.einsum('bnjhk,bnjhv->bnhkv', k_end, v)
    a_chunk = jnp.exp(g_last)

    def step(s, inp):
        a_c, ds_c = inp
        return a_c[..., None] * s + ds_c, s

    s_fin, s_start = lax.scan(step, s0, (jnp.moveaxis(a_chunk, 1, 0), jnp.moveaxis(ds, 1, 0)))
    s_start = jnp.moveaxis(s_start, 0, 1)
    o_inter = jnp.einsum('bnihk,bnhkv->bnihv', q * jnp.exp(g), s_start)
    return (o_intra + o_inter).reshape(bsz, seq_len, q.shape[3], v.shape[-1]), s_fin


def _chunk_gated_delta(q, k, v, beta, log_a, s0):
    bsz, seq_len, n_h, dk = q.shape
    c = math.gcd(seq_len, CHUNK)
    q, k, v = (_to_chunks(t, c).transpose(0, 1, 3, 2, 4) for t in (q, k, v))
    beta, log_a = (_to_chunks(t, c).transpose(0, 1, 3, 2) for t in (beta, log_a))
    g = jnp.cumsum(log_a, axis=-1)
    g_last = g[..., -1]
    incl = jnp.tril(jnp.ones((c, c), dtype=bool))
    strict = jnp.tril(jnp.ones((c, c), dtype=bool), -1)
    decay = jnp.exp(jnp.where(incl, g[..., :, None] - g[..., None, :], -jnp.inf))
    kk = jnp.einsum('bnhik,bnhjk->bnhij', k, k)
    a_mat = jnp.where(strict, beta[..., None] * kk * decay, 0.0)
    rhs = jnp.concatenate([(beta * jnp.exp(g))[..., None] * k, beta[..., None] * v], axis=-1)
    sol = lax.linalg.triangular_solve(a_mat, rhs, left_side=True, lower=True, unit_diagonal=True)
    w_mat, u0 = sol[..., :dk], sol[..., dk:]
    p_mat = jnp.einsum('bnhik,bnhjk->bnhij', q, k) * decay
    q_g = q * jnp.exp(g)[..., None]
    k_end = k * jnp.exp(g_last[..., None] - g)[..., None]
    a_chunk = jnp.exp(g_last)

    def step(s, inp):
        w_c, u0_c, p_c, qg_c, ke_c, a_c = inp
        u = u0_c - jnp.einsum('bhck,bhkv->bhcv', w_c, s)
        o = jnp.einsum('bhck,bhkv->bhcv', qg_c, s) + jnp.einsum('bhij,bhjv->bhiv', p_c, u)
        s = a_c[..., None, None] * s + jnp.einsum('bhck,bhcv->bhkv', ke_c, u)
        return s, o

    xs = tuple(jnp.moveaxis(t, 1, 0) for t in (w_mat, u0, p_mat, q_g, k_end, a_chunk))
    s_fin, o = lax.scan(step, s0, xs)
    o = jnp.moveaxis(o, 0, 1).transpose(0, 1, 3, 2, 4)
    return o.reshape(bsz, seq_len, n_h, v.shape[-1]), s_fin


def _trunk(x, pos, states, p, out_dtype):
    f32 = jnp.float32
    st_hg, st_gd, st_gc, st_rt, st_sd, st_sc = states
    bsz, seq_len = x.shape[:2]
    x = x.astype(f32)
    split_at = [int(i) for i in np.cumsum(SPLIT_SIZES)[:-1]]
    sm = jax.nn.softmax(p['hgrn_lb_logits'].astype(f32), axis=0)
    lower_bounds = jnp.cumsum(sm, axis=0) - sm[0]
    log_gamma = jnp.log(1.0 - jnp.exp2(-5.0 - jnp.arange(N_HEADS, dtype=f32)))
    rep = N_HEADS // SSD_GROUPS
    gsz = GROUP_WIDTH // SSD_GROUPS
    new = ([], [], [], [], [], [])
    for l in range(DEPTH):
        h = _rms(x) * p['norm_mix'][l]
        proj = h @ p['w_in'][l]
        (hq, hf, hi, hg, gqkv, gz, ga, gb, rq, rk, rv, rg, sz, sxbc, sdt) = jnp.split(proj, split_at, axis=-1)

        f = lower_bounds[l] + (1.0 - lower_bounds[l]) * jax.nn.sigmoid(hf)
        o_a, s_a = _chunk_vector_decay(_heads(jax.nn.sigmoid(hq)), _heads(1.0 - f), _heads(hi),
                                       _heads(jnp.log(f)), st_hg[l].astype(f32))
        o_a = _rms(o_a) * p['hgrn_norm'][l] * jax.nn.silu(_heads(hg))

        qkv, c_b = _causal_conv(gqkv, st_gc[l], p['gdn_conv_w'][l])
        gq, gk, gv = jnp.split(jax.nn.silu(qkv), 3, axis=-1)
        beta = jax.nn.sigmoid(gb)
        log_alpha = -jnp.exp(p['gdn_a_log'][l]) * jax.nn.softplus(ga + p['gdn_dt_bias'][l])
        o_b, s_b = _chunk_gated_delta(_l2norm(_heads(gq)) * HEAD_DIM ** -0.5, _l2norm(_heads(gk)),
                                      _heads(gv), beta, log_alpha, st_gd[l].astype(f32))
        o_b = _rms(o_b) * p['gdn_norm'][l] * jax.nn.silu(_heads(gz))

        rq_h = _rotary(_heads(rq), pos)
        rk_h = _rotary(_heads(rk), pos) * HEAD_DIM ** -0.5
        log_a_c = jnp.broadcast_to(log_gamma, (bsz, seq_len, N_HEADS))
        o_c, s_c = _chunk_scalar_decay(rq_h, rk_h, _heads(rv), log_a_c, st_rt[l].astype(f32))
        o_c = _rms(o_c) * jax.nn.silu(_heads(rg))

        xbc, c_d = _causal_conv(sxbc, st_sc[l], p['ssd_conv_w'][l])
        xbc = jax.nn.silu(xbc + p['ssd_conv_b'][l])
        xs, bmat, cmat = jnp.split(xbc, [GROUP_WIDTH, GROUP_WIDTH + SSD_GROUPS * SSD_STATE], axis=-1)
        xs = _heads(xs)
        bmat = jnp.repeat(bmat.reshape(bsz, seq_len, SSD_GROUPS, SSD_STATE), rep, axis=2)
        cmat = jnp.repeat(cmat.reshape(bsz, seq_len, SSD_GROUPS, SSD_STATE), rep, axis=2)
        dt = jax.nn.softplus(sdt + p['ssd_dt_bias'][l])
        log_a_d = -jnp.exp(p['ssd_a_log'][l]) * dt
        y_d, s_d = _chunk_scalar_decay(cmat, bmat, xs * dt[..., None], log_a_d, st_sd[l].astype(f32))
        y_d = (y_d + p['ssd_d'][l][:, None] * xs).reshape(bsz, seq_len, GROUP_WIDTH) * jax.nn.silu(sz)
        y_d = _rms(y_d.reshape(bsz, seq_len, SSD_GROUPS, gsz)).reshape(bsz, seq_len, GROUP_WIDTH) * p['ssd_norm'][l]

        mix = jnp.concatenate([o_a.reshape(bsz, seq_len, GROUP_WIDTH), o_b.reshape(bsz, seq_len, GROUP_WIDTH),
                               o_c.reshape(bsz, seq_len, GROUP_WIDTH), y_d], axis=-1)
        x = x + mix @ p['w_out'][l]
        h = _rms(x) * p['norm_ffn'][l]
        x = x + jnp.square(jax.nn.relu(h @ p['w_up'][l])) @ p['w_down'][l]
        for lst, s in zip(new, (s_a, s_b, c_b, s_c, s_d, c_d)):
            lst.append(s.astype(out_dtype))
    y = (_rms(x) * p['norm_final']).astype(out_dtype)
    return y, tuple(jnp.stack(lst) for lst in new)


def _dt_bias(k, shape):
    dt = jnp.exp(jax.random.uniform(k, shape, jnp.float32, math.log(1e-3), math.log(1e-1)))
    return dt + jnp.log(-jnp.expm1(-dt))


def setup_inputs(seed: int = 0) -> dict:
    key = jax.random.key(seed)
    ks = jax.random.split(key, 32)
    f32 = jnp.float32

    def nrm(k, shape, s):
        return jax.random.normal(k, shape, f32) * s

    H, K = N_HEADS, HEAD_DIM
    return {
        'x_prompt': nrm(ks[0], (BATCH, SEQ, D_MODEL), 1.0),
        'x_sample': nrm(ks[1], (DEC_BATCH, DEC_SEQ, D_MODEL), 1.0),
        'state_hgrn': nrm(ks[2], (DEPTH, DEC_BATCH, H, K, K), 0.5),
        'state_gdn': nrm(ks[3], (DEPTH, DEC_BATCH, H, K, K), 0.3),
        'state_gdn_conv': nrm(ks[4], (DEPTH, DEC_BATCH, CONV_WIDTH - 1, GDN_CONV_CH), 1.0),
        'state_ret': nrm(ks[5], (DEPTH, DEC_BATCH, H, K, K), 1.0),
        'state_ssd': nrm(ks[6], (DEPTH, DEC_BATCH, H, SSD_STATE, K), 0.3),
        'state_ssd_conv': nrm(ks[7], (DEPTH, DEC_BATCH, CONV_WIDTH - 1, SSD_CONV_CH), 1.0),
        'norm_mix': 1.0 + nrm(ks[8], (DEPTH, D_MODEL), 0.02),
        'w_in': nrm(ks[9], (DEPTH, D_MODEL, P_TOTAL), D_MODEL ** -0.5),
        'hgrn_lb_logits': nrm(ks[10], (DEPTH, GROUP_WIDTH), 0.5),
        'hgrn_norm': 1.0 + nrm(ks[11], (DEPTH, HEAD_DIM), 0.02),
        'gdn_conv_w': nrm(ks[12], (DEPTH, CONV_WIDTH, GDN_CONV_CH), CONV_WIDTH ** -0.5),
        'gdn_a_log': jnp.log(jax.random.uniform(ks[13], (DEPTH, H), f32, 1.0, 16.0)),
        'gdn_dt_bias': _dt_bias(ks[14], (DEPTH, H)),
        'gdn_norm': 1.0 + nrm(ks[15], (DEPTH, HEAD_DIM), 0.02),
        'ssd_conv_w': nrm(ks[16], (DEPTH, CONV_WIDTH, SSD_CONV_CH), CONV_WIDTH ** -0.5),
        'ssd_conv_b': nrm(ks[17], (DEPTH, SSD_CONV_CH), 0.02),
        'ssd_dt_bias': _dt_bias(ks[18], (DEPTH, H)),
        'ssd_a_log': jnp.log(jax.random.uniform(ks[19], (DEPTH, H), f32, 1.0, 16.0)),
        'ssd_d': 1.0 + nrm(ks[20], (DEPTH, H), 0.1),
        'ssd_norm': 1.0 + nrm(ks[21], (DEPTH, GROUP_WIDTH), 0.02),
        'w_out': nrm(ks[22], (DEPTH, MIX_WIDTH, D_MODEL), MIX_WIDTH ** -0.5),
        'norm_ffn': 1.0 + nrm(ks[23], (DEPTH, D_MODEL), 0.02),
        'w_up': nrm(ks[24], (DEPTH, D_MODEL, D_FF), D_MODEL ** -0.5),
        'w_down': nrm(ks[25], (DEPTH, D_FF, D_MODEL), D_FF ** -0.5),
        'norm_final': 1.0 + nrm(ks[26], (D_MODEL,), 0.02),
    }


def reference(x_prompt, x_sample, state_hgrn, state_gdn, state_gdn_conv, state_ret, state_ssd, state_ssd_conv,
              norm_mix, w_in, hgrn_lb_logits, hgrn_norm, gdn_conv_w, gdn_a_log, gdn_dt_bias, gdn_norm,
              ssd_conv_w, ssd_conv_b, ssd_dt_bias, ssd_a_log, ssd_d, ssd_norm,
              w_out, norm_ffn, w_up, w_down, norm_final):
    params = dict(norm_mix=norm_mix, w_in=w_in, hgrn_lb_logits=hgrn_lb_logits, hgrn_norm=hgrn_norm,
                  gdn_conv_w=gdn_conv_w, gdn_a_log=gdn_a_log, gdn_dt_bias=gdn_dt_bias, gdn_norm=gdn_norm,
                  ssd_conv_w=ssd_conv_w, ssd_conv_b=ssd_conv_b, ssd_dt_bias=ssd_dt_bias, ssd_a_log=ssd_a_log,
                  ssd_d=ssd_d, ssd_norm=ssd_norm, w_out=w_out, norm_ffn=norm_ffn, w_up=w_up,
                  w_down=w_down, norm_final=norm_final)
    out_dtype = x_prompt.dtype
    bp, lp = x_prompt.shape[:2]
    ls = x_sample.shape[1]
    sample_states = (state_hgrn, state_gdn, state_gdn_conv, state_ret, state_ssd, state_ssd_conv)
    prompt_states = tuple(jnp.zeros((DEPTH, bp) + s.shape[2:], jnp.float32) for s in sample_states)
    y_prompt, (hgrn_p, gdn_p, gdnc_p, ret_p, ssd_p, ssdc_p) = _trunk(
        x_prompt, jnp.arange(lp), prompt_states, params, out_dtype)
    y_sample, (hgrn_s, gdn_s, gdnc_s, ret_s, ssd_s, ssdc_s) = _trunk(
        x_sample, PAST_LEN + jnp.arange(ls), sample_states, params, out_dtype)
    return (y_prompt, y_sample, hgrn_p, hgrn_s, gdn_p, gdn_s, gdnc_p, gdnc_s,
            ret_p, ret_s, ssd_p, ssd_s, ssdc_p, ssdc_s)
```

```cpp
#include <hip/hip_runtime.h>
#include <hip/hip_cooperative_groups.h>
#include <cstdio>
namespace cg = cooperative_groups;

#define LAS __attribute__((address_space(3)))
typedef _Float16 f16_t;
typedef _Float16 f16x8 __attribute__((ext_vector_type(8)));
typedef _Float16 f16x2 __attribute__((ext_vector_type(2)));
typedef float f32x4 __attribute__((ext_vector_type(4)));
typedef unsigned u32x4 __attribute__((ext_vector_type(4)));
typedef unsigned u32x2 __attribute__((ext_vector_type(2)));
typedef float f32x2 __attribute__((ext_vector_type(2)));

constexpr int DM = 1024, NB = 8, SEQ = 2048, NSB = 128, SL = 4, PASTLEN = 16384;
constexpr int TP = NB * SEQ, TS = NSB * SL, TT = TP + TS;
constexpr int PTOT = 4108, PN = 4352, DFF = 4096;
constexpr float EPS = 1e-6f;
constexpr int C_HQ = 0, C_HF = 256, C_HI = 512, C_HG = 768, C_GQKV = 1024, C_GZ = 1792, C_GA = 2048, C_GB = 2052,
              C_RQ = 2056, C_RK = 2312, C_RV = 2568, C_RG = 2824, C_SZ = 3080, C_SXBC = 3336, C_SDT = 4104;
constexpr long O_Y = 0;
constexpr long O_HGRN_P = (long)TT * DM;
constexpr long O_HGRN_S = O_HGRN_P + 2L * NB * 4 * 64 * 64;
constexpr long O_GDN_P = O_HGRN_S + 2L * NSB * 4 * 64 * 64;
constexpr long O_GDN_S = O_GDN_P + 2L * NB * 4 * 64 * 64;
constexpr long O_GDNC_P = O_GDN_S + 2L * NSB * 4 * 64 * 64;
constexpr long O_GDNC_S = O_GDNC_P + 2L * NB * 3 * 768;
constexpr long O_RET_P = O_GDNC_S + 2L * NSB * 3 * 768;
constexpr long O_RET_S = O_RET_P + 2L * NB * 4 * 64 * 64;
constexpr long O_SSD_P = O_RET_S + 2L * NSB * 4 * 64 * 64;
constexpr long O_SSD_S = O_SSD_P + 2L * NB * 4 * 128 * 64;
constexpr long O_SSDC_P = O_SSD_S + 2L * NSB * 4 * 128 * 64;
constexpr long O_SSDC_S = O_SSDC_P + 2L * NB * 3 * 768;
constexpr long O_END = O_SSDC_S + 2L * NSB * 3 * 768;
constexpr size_t WT_WIN = 0, WT_WOUT = WT_WIN + (size_t)PN * DM * 2, WT_WUP = WT_WOUT + (size_t)DM * DM * 2, WT_WDOWN = WT_WUP + (size_t)DFF * DM * 2,
                 WT_LAYER = WT_WDOWN + (size_t)DM * DFF * 2;
constexpr size_t WS_WT = 0, WS_XN = WS_WT + 2 * WT_LAYER, WS_PROJ = WS_XN + (size_t)TT * DM * 2, WS_SCR = WS_PROJ + (size_t)TT * PN * 2,
                 WS_BAR = WS_SCR + (size_t)8 * TS * DM * 4,
                 WS_END = WS_BAR + 16384;
constexpr int LDS_BYTES = 131072 + 64;

struct Params { const float* in[27]; float* out; unsigned char* ws; };

__device__ __forceinline__ void h2f(unsigned w, float& a, float& b) { f16x2 v = __builtin_bit_cast(f16x2, w); a = (float)v.x; b = (float)v.y; }
__device__ __forceinline__ unsigned pkh(float a, float b) { f16x2 v; v.x = (f16_t)a; v.y = (f16_t)b; return __builtin_bit_cast(unsigned, v); }
__device__ __forceinline__ float hload(const f16_t* p) { return (float)(*p); }
__device__ __forceinline__ float sigmoidf_(float x) { return 1.0f / (1.0f + __expf(-x)); }
__device__ __forceinline__ float siluf_(float x) { return x / (1.0f + __expf(-x)); }
__device__ __forceinline__ float softplusf_(float x) { return x > 20.f ? x : log1pf(expf(x)); }
template <int CTRL> __device__ __forceinline__ float dppf(float x) { return __builtin_bit_cast(float, __builtin_amdgcn_update_dpp(0, __builtin_bit_cast(int, x), CTRL, 0xF, 0xF, true)); }
__device__ __forceinline__ float red4(float x) { x += dppf<0xB1>(x); x += dppf<0x4E>(x); return x; }
__device__ __forceinline__ float red8(float x) { x = red4(x); x += dppf<0x141>(x); return x; }
__device__ __forceinline__ float red16(float x) { x = red8(x); x += dppf<0x140>(x); return x; }
__device__ __forceinline__ void u4f(const u32x4& u, float (&f)[8]) { h2f(u.x, f[0], f[1]); h2f(u.y, f[2], f[3]); h2f(u.z, f[4], f[5]); h2f(u.w, f[6], f[7]); }
__device__ __forceinline__ void u2f(const u32x2& u, float (&f)[4]) { h2f(u.x, f[0], f[1]); h2f(u.y, f[2], f[3]); }
__device__ __forceinline__ float red64(float x) { x = red16(x); x += __shfl_xor(x, 16); x += __shfl_xor(x, 32); return x; }

__device__ __forceinline__ int tidx() { int t = threadIdx.x; asm volatile("" : "+v"(t)); return t; }
__device__ __forceinline__ int bidx() { int t = blockIdx.x; asm volatile("" : "+s"(t)); return t; }

typedef const __attribute__((address_space(4))) Params* KArgP;
__device__ __forceinline__ KArgP kargs() { KArgP pp = (KArgP)__builtin_amdgcn_kernarg_segment_ptr(); asm volatile("" : "+s"(pp)); return pp; }
__device__ __forceinline__ const float* pin(int i) { return kargs()->in[i]; }
__device__ __forceinline__ float* pout() { return kargs()->out; }
__device__ __forceinline__ unsigned char* pws() { return kargs()->ws; }

#define XB_TMO      128
#define XB_XCNT(j)  (256  + 64 * (j))
#define XB_XSUB(j)  (1280 + 64 * (j))
#define XB_XGEN(j)  (2304 + 64 * (j))
#define XB_TOP      3328
#define XB_TOPGEN   3392
#define XCD_BAR_WORDS 3456
#define XB_SPIN_CAP (1u << 18)
__device__ __forceinline__ unsigned xb_ld(unsigned* p)              { return __hip_atomic_load(p, __ATOMIC_RELAXED, __HIP_MEMORY_SCOPE_AGENT); }
__device__ __forceinline__ unsigned xb_add(unsigned* p, unsigned v) { return __hip_atomic_fetch_add(p, v, __ATOMIC_RELAXED, __HIP_MEMORY_SCOPE_AGENT); }
__device__ __forceinline__ unsigned xb_xcc_id() { return (unsigned)__builtin_amdgcn_s_getreg((3 << 11) | 20) & 0xFu; }
#define XB_SPIN(cond, bar) do { unsigned _sp = 0; while (cond) { __builtin_amdgcn_s_sleep(1); \
    if ((++_sp & 255u) == 0u) { if (xb_ld(&(bar)[XB_TMO])) break; if (_sp > XB_SPIN_CAP) { atomicAdd(&(bar)[XB_TMO], 1u); break; } } } } while (0)
struct XcdBarrier { unsigned* bar; unsigned x; volatile LAS unsigned* st; };
__device__ __forceinline__ XcdBarrier xcd_barrier_post(unsigned* bar, volatile LAS unsigned* st) {
    XcdBarrier b; b.bar = bar; b.x = xb_xcc_id(); b.st = st;
    if (threadIdx.x == 0) (void)xb_add(&bar[XB_XCNT(b.x)], 1u);
    return b;
}
__device__ __forceinline__ void xcd_barrier_complete(unsigned* bar, unsigned x, unsigned& nloc, unsigned& nx) {
    const unsigned G = gridDim.x * gridDim.y * gridDim.z;
    unsigned sum, cnt, mine, sp = 0u;
    for (;;) {
        sum = 0u; cnt = 0u; mine = 0u;
#pragma unroll
        for (unsigned j = 0; j < 16; ++j) { const unsigned c = xb_ld(&bar[XB_XCNT(j)]); sum += c; cnt += (c > 0u) ? 1u : 0u; mine = (j == x) ? c : mine; }
        if (sum == G) break;
        __builtin_amdgcn_s_sleep(1);
        if ((++sp & 255u) == 0u) { if (xb_ld(&bar[XB_TMO])) break; if (sp > XB_SPIN_CAP) { atomicAdd(&bar[XB_TMO], 1u); break; } }
    }
    nloc = mine > 0u ? mine : 1u; nx = cnt > 0u ? cnt : 1u;
}
__device__ __forceinline__ void xcd_barrier(const XcdBarrier& b) {
    asm volatile("s_waitcnt vmcnt(0)" ::: "memory");
    __syncthreads();
    if (threadIdx.x == 0) {
        unsigned* bar = b.bar;
        __builtin_amdgcn_s_waitcnt(0);
        unsigned nloc = b.st[0], nx = b.st[1];
        if (nloc == 0u) { xcd_barrier_complete(bar, b.x, nloc, nx); b.st[0] = nloc; b.st[1] = nx; }
        const unsigned old = xb_add(&bar[XB_XSUB(b.x)], 1u);
        const unsigned gen = old / nloc;
        if (old + 1u == (gen + 1u) * nloc) {
            __builtin_amdgcn_fence(__ATOMIC_RELEASE, "agent");
            asm volatile("s_waitcnt vmcnt(0)" ::: "memory");
            const unsigned og = xb_add(&bar[XB_TOP], 1u);
            const unsigned tg = og / nx;
            if (og + 1u == (tg + 1u) * nx) xb_add(&bar[XB_TOPGEN], 1u);
            else XB_SPIN(xb_ld(&bar[XB_TOPGEN]) == tg, bar);
            __builtin_amdgcn_fence(__ATOMIC_ACQUIRE, "agent");
            xb_add(&bar[XB_XGEN(b.x)], 1u);
            asm volatile("s_waitcnt vmcnt(0)" ::: "memory");
        } else {
            XB_SPIN(xb_ld(&bar[XB_XGEN(b.x)]) == gen, bar);
            __builtin_amdgcn_fence(__ATOMIC_ACQUIRE, "agent");
            asm volatile("s_waitcnt vmcnt(0)" ::: "memory");
        }
    }
    __syncthreads();
}

namespace pg8 {
constexpr int BM = 256, BK = 64, HALF = 128, HTB = HALF * BK * 2, STAGE_BYTES = 8 * HTB, NXCD = 8, WGM = 8;
__host__ __device__ __forceinline__ int lds_byte(int r, int c) { const int st = (r >> 4) * 2 + (c >> 5), rr = r & 15, cc = c & 31, ob = rr * 64 + cc * 2; return st * 1024 + (ob ^ (((ob >> 9) & 1) << 5)); }
__host__ __device__ __forceinline__ void stage_rc(int b, int& R, int& C) { const int st = b / 1024, sb = b % 1024, swz = sb ^ (((sb >> 9) & 1) << 5); R = (st >> 1) * 16 + swz / 64; C = (st & 1) * 32 + (swz % 64) / 2; }
__host__ __device__ __forceinline__ int perm32(int rho) { const int n = rho >> 4, i = rho & 15; return 8 * (i >> 2) + 4 * n + (i & 3); }
struct Unit { int pm, pn, k0, nt, sl; };
struct Gemm { const f16_t* A; const f16_t* Bt; int M, N, K; };
struct PowOrder {
    int G, c, lnN, ntot, nsu, lsplit, n17;
    __device__ __forceinline__ bool next(int i, Unit& u) const {
        const int L = i * G + c, nwg = 64 << lnN, e = L - nwg, ns = nsu << lsplit, f = e - ns;
        const bool mainp = L < nwg, samp = !mainp && e < ns;
        const int wgid = (L & 7) * (nwg >> 3) + (L >> 3), within = wgid & ((8 << lnN) - 1);
        const int su = e >> lsplit, sl = e & ((1 << lsplit) - 1), nts = ntot >> lsplit;
        const int pm = mainp ? (wgid >> (3 + lnN)) * 8 + (within & 7) : (samp ? 64 + (su >> lnN) : f);
        const int pn = mainp ? within >> 3 : (samp ? su & ((1 << lnN) - 1) : (1 << lnN));
        const int k0 = (samp && lsplit) ? -1 - sl * nts : 0;
        const int nt = samp ? nts : ntot;
        u.pm = pm; u.pn = pn; u.k0 = k0; u.nt = nt; u.sl = sl;
        return mainp || samp || f < n17;
    }
    __device__ __forceinline__ void a_ready(const Unit&) const {}
    __device__ __forceinline__ void done(const Unit&) const {}
};
struct EpiAny {
    int mode; void* out; int ldc; float* scr;
    __device__ __forceinline__ bool perm() const { return mode != 2; }
    __device__ __forceinline__ void operator()(const f32x4 (&acc)[2][2][4][2], const Unit& u, int wr, int wc, int fr, int fq) const {
        if (mode == 2) {
            float* C = (float*)out;
            const int row0 = u.pm * BM + wr * 64 + fr, col0 = u.pn * BM + wc * 32 + 4 * fq;
#pragma unroll
            for (int ai = 0; ai < 2; ++ai)
#pragma unroll
                for (int m = 0; m < 4; ++m) { float* rowp = C + (size_t)(row0 + ai * HALF + m * 16) * ldc + col0;
#pragma unroll
                    for (int bj = 0; bj < 2; ++bj)
#pragma unroll
                        for (int n = 0; n < 2; ++n) { float* q = rowp + bj * HALF + n * 16; const f32x4 v = acc[ai][bj][m][n];
                            if (u.k0 < 0) *(f32x4*)(scr + (size_t)u.sl * TS * DM + (q - C) - (size_t)64 * BM * ldc) = v;
                            else *(f32x4*)q = *(f32x4*)q + v; } }
        } else {
            f16_t* O = (f16_t*)out;
            const int row0 = u.pm * BM + wr * 64 + fr; const int col0 = u.pn * BM + wc * 32 + 8 * fq;
            const float lo = mode == 1 ? 0.f : -3.0e38f;
#pragma unroll
            for (int ai = 0; ai < 2; ++ai)
#pragma unroll
                for (int m = 0; m < 4; ++m) { f16_t* rowp = O + (size_t)(row0 + ai * HALF + m * 16) * ldc + col0;
#pragma unroll
                    for (int bj = 0; bj < 2; ++bj) { f32x4 v0 = acc[ai][bj][m][0], v1 = acc[ai][bj][m][1];
                        if (mode == 1) {
#pragma unroll
                            for (int j = 0; j < 4; ++j) { float a = fmaxf(v0[j], lo), b = fmaxf(v1[j], lo); v0[j] = a * a; v1[j] = b * b; } }
                        u32x4 w; w.x = pkh(v0[0], v0[1]); w.y = pkh(v0[2], v0[3]); w.z = pkh(v1[0], v1[1]); w.w = pkh(v1[2], v1[3]);
                        *(u32x4*)(rowp + bj * HALF) = w; } }
        }
    }
};

template <class Epi, class Sched>
__device__ __forceinline__ void gemm_phase(LAS unsigned char* lds, const Gemm g, const Sched& S, const Epi& E) {
    const int tid = tidx(), wid = __builtin_amdgcn_readfirstlane(tid >> 6), lane = tid & 63, wr = wid >> 2, wc = wid & 3, fr = lane & 15, fq = lane >> 4;
    const int K = g.K;
    unsigned voffA[2], voffB[2];
#pragma unroll
    for (int i = 0; i < 2; ++i) { int R, C; stage_rc(tid * 16 + i * 8192, R, C); const int Rb = E.perm() ? ((R & ~31) + perm32(R & 31)) : R;
        voffA[i] = (unsigned)(R * K + C) * 2u; voffB[i] = (unsigned)(Rb * K + C) * 2u; }
    const size_t kstep = (size_t)(BK * 2);
    const size_t hstep = (size_t)HALF * K * 2;
    const size_t tstep = 2 * hstep;
    const unsigned ldsw = (unsigned)wid * 1024u;
    const int aoff = lds_byte(wr * 64 + fr, fq * 8), boff = lds_byte(wc * 32 + fr, fq * 8);
#define PG8_SA(b, h) (((b) * 2 + (h)) * HTB)
#define PG8_SB(b, h) ((4 + (b) * 2 + (h)) * HTB)
#define PG8_STAGE(bufoff, gbase, voff) do { _Pragma("unroll") for (int _i = 0; _i < 2; ++_i) \
        __builtin_amdgcn_global_load_lds((const unsigned*)((const char*)(gbase) + (voff)[_i]), (LAS unsigned*)(lds + (bufoff) + ldsw + _i * 8192), 16, 0, 0); } while (0)
#define PG8_LDA(dst, b, h) do { _Pragma("unroll") for (int m = 0; m < 4; ++m) _Pragma("unroll") for (int k = 0; k < 2; ++k) dst[m][k] = *(const LAS f16x8*)(lds + PG8_SA(b, h) + aoff + m * 2048 + k * 1024); } while (0)
#define PG8_LDB(dst, b, h) do { _Pragma("unroll") for (int n = 0; n < 2; ++n) _Pragma("unroll") for (int k = 0; k < 2; ++k) dst[n][k] = *(const LAS f16x8*)(lds + PG8_SB(b, h) + boff + n * 2048 + k * 1024); } while (0)
#define PG8_MMA(ai, bj, At, Bt) do { __builtin_amdgcn_s_setprio(1); _Pragma("unroll") for (int m = 0; m < 4; ++m) _Pragma("unroll") for (int n = 0; n < 2; ++n) _Pragma("unroll") for (int k = 0; k < 2; ++k) \
        acc[ai][bj][m][n] = __builtin_amdgcn_mfma_f32_16x16x32_f16(Bt[n][k], At[m][k], acc[ai][bj][m][n], 0, 0, 0); __builtin_amdgcn_s_setprio(0); } while (0)
#define PG8_WAIT_V(n) asm volatile("s_waitcnt vmcnt(" #n ")" ::: "memory")
#define PG8_WAIT_L(n) asm volatile("s_waitcnt lgkmcnt(" #n ")" ::: "memory")
#define PG8_BAR __builtin_amdgcn_s_barrier()
#define PG8_SCHED __builtin_amdgcn_sched_barrier(0)
    Unit cur, nxt; int ui = 0;
    if (!S.next(0, cur)) return;
    f32x4 acc[2][2][4][2];
#pragma unroll
    for (int a = 0; a < 2; ++a)
#pragma unroll
        for (int b = 0; b < 2; ++b)
#pragma unroll
            for (int m = 0; m < 4; ++m)
#pragma unroll
                for (int n = 0; n < 2; ++n) acc[a][b][m][n] = (f32x4){0.f, 0.f, 0.f, 0.f};
    f16x8 At[4][2], B0[2][2], B1[2][2];
    const char* cA = (const char*)g.A + (size_t)cur.pm * tstep + (size_t)(cur.k0 < 0 ? -1 - cur.k0 : cur.k0) * kstep; const char* cB = (const char*)g.Bt + (size_t)cur.pn * tstep + (size_t)(cur.k0 < 0 ? -1 - cur.k0 : cur.k0) * kstep;
    S.a_ready(cur);
    PG8_STAGE(PG8_SB(0, 0), cB, voffB); PG8_STAGE(PG8_SA(0, 0), cA, voffA); PG8_STAGE(PG8_SB(0, 1), cB + hstep, voffB); PG8_STAGE(PG8_SA(0, 1), cA + hstep, voffA);
    if (wr == 1) PG8_BAR;
    PG8_WAIT_V(4); PG8_BAR;
    PG8_STAGE(PG8_SB(1, 0), cB + kstep, voffB); PG8_STAGE(PG8_SA(1, 0), cA + kstep, voffA); PG8_STAGE(PG8_SB(1, 1), cB + hstep + kstep, voffB);
    PG8_WAIT_V(6); PG8_BAR;
    for (;;) {
        const bool has_next = S.next(ui + 1, nxt);
        const char* nA = has_next ? (const char*)g.A + (size_t)nxt.pm * tstep + (size_t)(nxt.k0 < 0 ? -1 - nxt.k0 : nxt.k0) * kstep : cA; const char* nB = has_next ? (const char*)g.Bt + (size_t)nxt.pn * tstep + (size_t)(nxt.k0 < 0 ? -1 - nxt.k0 : nxt.k0) * kstep : cB;
        const int nt = cur.nt;
        for (int t = 0; t < nt; t += 2) {
            const bool last = (t == nt - 2);
            const char* a1 = cA + (size_t)(t + 1) * kstep;
            const char* a2 = last ? nA : cA + (size_t)(t + 2) * kstep; const char* b2 = last ? nB : cB + (size_t)(t + 2) * kstep;
            const char* a3 = a2 + kstep; const char* b3 = b2 + kstep;
            if (last && has_next) S.a_ready(nxt);
            PG8_LDB(B0, 0, 0); PG8_SCHED; PG8_LDA(At, 0, 0); PG8_STAGE(PG8_SA(1, 1), a1 + hstep, voffA);
            PG8_WAIT_L(8); PG8_BAR; PG8_WAIT_L(0); PG8_MMA(0, 0, At, B0); PG8_BAR; PG8_SCHED;
            PG8_LDB(B1, 0, 1); PG8_STAGE(PG8_SB(0, 0), b2, voffB);
            PG8_BAR; PG8_WAIT_L(0); PG8_MMA(0, 1, At, B1); PG8_BAR;
            PG8_LDA(At, 0, 1); PG8_STAGE(PG8_SA(0, 0), a2, voffA);
            PG8_BAR; PG8_WAIT_L(0); PG8_MMA(1, 0, At, B0); PG8_BAR; PG8_SCHED;
            PG8_STAGE(PG8_SB(0, 1), b2 + hstep, voffB);
            PG8_WAIT_V(6); PG8_BAR; PG8_MMA(1, 1, At, B1); PG8_BAR;
            PG8_LDB(B0, 1, 0); PG8_SCHED; PG8_LDA(At, 1, 0); PG8_STAGE(PG8_SA(0, 1), a2 + hstep, voffA);
            PG8_WAIT_L(8); PG8_BAR; PG8_WAIT_L(0); PG8_MMA(0, 0, At, B0); PG8_BAR; PG8_SCHED;
            PG8_LDB(B1, 1, 1); PG8_STAGE(PG8_SB(1, 0), b3, voffB);
            PG8_BAR; PG8_WAIT_L(0); PG8_MMA(0, 1, At, B1); PG8_BAR;
            PG8_LDA(At, 1, 1); PG8_STAGE(PG8_SA(1, 0), a3, voffA);
            PG8_BAR; PG8_WAIT_L(0); PG8_MMA(1, 0, At, B0); PG8_BAR; PG8_SCHED;
            PG8_STAGE(PG8_SB(1, 1), b3 + hstep, voffB);
            PG8_WAIT_V(6); PG8_BAR; PG8_MMA(1, 1, At, B1); PG8_BAR;
        }
        E(acc, cur, wr, wc, fr, fq); S.done(cur);
        if (!has_next) break;
#pragma unroll
        for (int a = 0; a < 2; ++a)
#pragma unroll
            for (int b = 0; b < 2; ++b)
#pragma unroll
                for (int m = 0; m < 4; ++m)
#pragma unroll
                    for (int n = 0; n < 2; ++n) acc[a][b][m][n] = (f32x4){0.f, 0.f, 0.f, 0.f};
        cur = nxt; cA = nA; cB = nB; ++ui;
    }
    PG8_WAIT_V(0);
    if (wr == 0) PG8_BAR;
    PG8_BAR;
#undef PG8_SA
#undef PG8_SB
#undef PG8_STAGE
#undef PG8_LDA
#undef PG8_LDB
#undef PG8_MMA
#undef PG8_WAIT_V
#undef PG8_WAIT_L
#undef PG8_BAR
#undef PG8_SCHED
}
}

__device__ __forceinline__ void narrow_cols(const f16_t* XN, const f16_t* WinT, f16_t* PROJ) {
    const int tid = tidx(), lane = tid & 63, fr = lane & 15, fq = lane >> 4, gw = bidx() * 8 + (tid >> 6), nw = gridDim.x * 8;
    for (int t = gw; t < TT / 16; t += nw) {
        const f16_t* ap = XN + (size_t)(t * 16 + fr) * DM + fq * 8;
        const f16_t* bp = WinT + (size_t)(4096 + fr) * DM + fq * 8;
        f32x4 acc = (f32x4){0.f, 0.f, 0.f, 0.f};
#pragma unroll 8
        for (int kk = 0; kk < DM; kk += 32) acc = __builtin_amdgcn_mfma_f32_16x16x32_f16(*(const f16x8*)(ap + kk), *(const f16x8*)(bp + kk), acc, 0, 0, 0);
#pragma unroll
        for (int r = 0; r < 4; ++r) PROJ[(size_t)(t * 16 + fq * 4 + r) * PN + 4096 + fr] = (f16_t)acc[r];
    }
}
__device__ __forceinline__ void scr_zero() {
    f32x4* s = (f32x4*)(pws() + WS_SCR);
    for (int i = bidx() * 512 + tidx(); i < TS * 4096 / 4; i += gridDim.x * 512) s[i] = (f32x4){0.f, 0.f, 0.f, 0.f};
}
__device__ __forceinline__ void scr_convert(f16_t* O, int ldc, bool relu2) {
    const f32x4* s = (const f32x4*)(pws() + WS_SCR);
    for (int i = bidx() * 512 + tidx(); i < TS * 4096 / 4; i += gridDim.x * 512) {
        f32x4 v = s[i]; const int r = i >> 10, c = (i & 1023) * 4;
        if (relu2) {
#pragma unroll
            for (int j = 0; j < 4; ++j) { const float a = fmaxf(v[j], 0.f); v[j] = a * a; } }
        u32x2 w; w.x = pkh(v[0], v[1]); w.y = pkh(v[2], v[3]);
        *(u32x2*)(O + (size_t)(TP + r) * ldc + c) = w;
    }
}

__device__ __forceinline__ void norm_rows(const float* srcP, const float* srcS, float* X, f16_t* XN, const float* g, bool final_inplace, const float* scr = nullptr, int nsl = 0, bool copy_x = true) {
    const int lane = tidx() & 63, gw = bidx() * 8 + (tidx() >> 6), nw = gridDim.x * 8;
    f32x4 gv[4];
#pragma unroll
    for (int i = 0; i < 4; ++i) gv[i] = *(const f32x4*)(g + i * 256 + lane * 4);
    for (int r0 = gw; r0 < TT; r0 += 4 * nw) {
        f32x4 v[4][4];
#pragma unroll
        for (int b = 0; b < 4; ++b) { const int r = r0 + b * nw;
            if (r < TT) { const float* src = srcP ? (r < TP ? srcP + (size_t)r * DM : srcS + (size_t)(r - TP) * DM) : X + (size_t)r * DM;
#pragma unroll
                for (int i = 0; i < 4; ++i) v[b][i] = *(const f32x4*)(src + i * 256 + lane * 4); } }
#pragma unroll
        for (int b = 0; b < 4; ++b) { const int r = r0 + b * nw;
            if (r < TT) {
                float ss = 0.f;
#pragma unroll
                for (int i = 0; i < 4; ++i) {
                    if (nsl && r >= TP) {
                        const float* s = scr + (size_t)(r - TP) * DM + i * 256 + lane * 4;
                        for (int q = 0; q < nsl; ++q) v[b][i] = v[b][i] + *(const f32x4*)(s + (size_t)q * TS * DM);
                        if (!final_inplace) *(f32x4*)(X + (size_t)r * DM + i * 256 + lane * 4) = v[b][i]; }
                    ss += v[b][i][0] * v[b][i][0] + v[b][i][1] * v[b][i][1] + v[b][i][2] * v[b][i][2] + v[b][i][3] * v[b][i][3]; }
                ss = red64(ss);
                const float sc = rsqrtf(ss * (1.0f / DM) + EPS);
#pragma unroll
                for (int i = 0; i < 4; ++i) {
                    if (srcP && copy_x) *(f32x4*)(X + (size_t)r * DM + i * 256 + lane * 4) = v[b][i];
                    f32x4 o = v[b][i] * sc * gv[i];
                    if (final_inplace) *(f32x4*)(X + (size_t)r * DM + i * 256 + lane * 4) = o;
                    else { u32x2 w; w.x = pkh(o[0], o[1]); w.y = pkh(o[2], o[3]); *(u32x2*)(XN + (size_t)r * DM + i * 256 + lane * 4) = w; }
                } } }
    }
}

struct TileJob { const float* W; f16_t* Bt; int Kdim, Nreal, tk, tn; };
__device__ __forceinline__ TileJob tile_job(int t) {
    constexpr int n_in = 16 * (PN / 64), n_out = 16 * 16, n_up = 16 * 64, n_dn = 64 * 16, tot = n_in + n_out + n_up + n_dn;
    const int l = t >= tot ? 1 : 0, u0 = t - l * tot;
    f16_t* wt = (f16_t*)(pws() + WS_WT + l * WT_LAYER);
    TileJob j;
    if (u0 < n_in) { j = TileJob{pin(9) + (size_t)l * DM * PTOT, wt + WT_WIN / 2, DM, PTOT, u0 % 16, u0 / 16}; }
    else if (u0 < n_in + n_out) { const int u = u0 - n_in; j = TileJob{pin(22) + (size_t)l * DM * DM, wt + WT_WOUT / 2, DM, DM, u % 16, u / 16}; }
    else if (u0 < n_in + n_out + n_up) { const int u = u0 - n_in - n_out; j = TileJob{pin(24) + (size_t)l * DM * DFF, wt + WT_WUP / 2, DM, DFF, u % 16, u / 16}; }
    else { const int u = u0 - n_in - n_out - n_up; j = TileJob{pin(25) + (size_t)l * DFF * DM, wt + WT_WDOWN / 2, DFF, DM, u % 64, u / 64}; }
    return j;
}
__device__ __forceinline__ void tile_load(const TileJob& j, f32x4 (&v)[2]) {
    const int tid = tidx(), k0 = j.tk * 64, n0 = j.tn * 64;
#pragma unroll
    for (int i = 0; i < 2; ++i) { const int r = (tid >> 4) + 32 * i, c = (tid & 15) * 4, n = n0 + c;
        v[i] = (f32x4){0.f, 0.f, 0.f, 0.f};
        if (n < j.Nreal) v[i] = *(const f32x4*)(j.W + (size_t)(k0 + r) * j.Nreal + n); }
}
__device__ __forceinline__ void tile_store(const TileJob& j, const f32x4 (&v)[2], LAS float* tile) {
    const int tid = tidx(), k0 = j.tk * 64, n0 = j.tn * 64;
#pragma unroll
    for (int i = 0; i < 2; ++i) { const int r = (tid >> 4) + 32 * i, c = (tid & 15) * 4;
        tile[r * 65 + c] = v[i][0]; tile[r * 65 + c + 1] = v[i][1]; tile[r * 65 + c + 2] = v[i][2]; tile[r * 65 + c + 3] = v[i][3]; }
    __syncthreads();
    { const int nl = tid >> 3, k8 = (tid & 7) * 8; u32x4 w;
      w.x = pkh(tile[(k8 + 0) * 65 + nl], tile[(k8 + 1) * 65 + nl]); w.y = pkh(tile[(k8 + 2) * 65 + nl], tile[(k8 + 3) * 65 + nl]);
      w.z = pkh(tile[(k8 + 4) * 65 + nl], tile[(k8 + 5) * 65 + nl]); w.w = pkh(tile[(k8 + 6) * 65 + nl], tile[(k8 + 7) * 65 + nl]);
      *(u32x4*)(j.Bt + (size_t)(n0 + nl) * j.Kdim + k0 + k8) = w; }
    __syncthreads();
}
__device__ __forceinline__ void convert_tiles(int t0, int t1, int step, LAS float* tile) {
    int t = t0;
    if (t < t1) {
        TileJob cur = tile_job(t); f32x4 v[2]; tile_load(cur, v);
        for (;;) {
            const int tn = t + step; const bool more = tn < t1;
            TileJob nxt = cur; f32x4 vn[2];
            if (more) { nxt = tile_job(tn); tile_load(nxt, vn); }
            tile_store(cur, v, tile);
            if (!more) break;
            cur = nxt; v[0] = vn[0]; v[1] = vn[1]; t = tn;
        }
    }
}
constexpr int N_TILES_WIN0 = 16 * (PN / 64);
constexpr int N_TILES_ALL = 2 * (16 * (PN / 64) + 16 * 16 + 16 * 64 + 64 * 16);
__device__ __forceinline__ void phase_prologue(const Params& p, LAS unsigned char* lds) {
    convert_tiles(bidx(), N_TILES_WIN0, gridDim.x, (LAS float*)lds);
    norm_rows(pin(0), pin(1), pout() + O_Y, (f16_t*)(pws() + WS_XN), pin(8), false, nullptr, 0, false);
}
__device__ __forceinline__ void copy_x_rows(int r0, int n) {
    const f32x4* xp = (const f32x4*)pin(0); const f32x4* xs = (const f32x4*)pin(1); f32x4* X = (f32x4*)(pout() + O_Y);
    for (int i = tidx(); i < n * 256; i += 512) { const size_t e = (size_t)r0 * 256 + i;
        X[e] = e < (size_t)TP * 256 ? xp[e] : xs[e - (size_t)TP * 256]; }
}

__device__ __forceinline__ void phase_conv(const Params& p, int l, const XcdBarrier& xbar) {
    f16_t* proj = (f16_t*)(pws() + WS_PROJ);
    const int g = bidx() * 512 + tidx();
    constexpr int NPI = (TP / 32) * 192, NSI = NSB * 192;
    const int kind = g < NPI ? 0 : (g - NPI < NSI ? 1 : 2);
    const int gi = kind == 0 ? g : (kind == 1 ? g - NPI : 0);
    const int cgi = gi % 192, unit = gi / 192;
    const bool ssd = cgi >= 96; const int ch = (ssd ? cgi - 96 : cgi) * 8;
    const int col = (ssd ? C_SXBC : C_GQKV) + ch;
    const float* cw = (ssd ? pin(16) : pin(12)) + (size_t)l * 4 * 768 + ch;
    float w[4][8], bias[8];
#pragma unroll
    for (int j = 0; j < 4; ++j) { const f32x4 a = *(const f32x4*)(cw + j * 768), b = *(const f32x4*)(cw + j * 768 + 4);
#pragma unroll
        for (int e = 0; e < 4; ++e) { w[j][e] = a[e]; w[j][e + 4] = b[e]; } }
#pragma unroll
    for (int e = 0; e < 8; ++e) bias[e] = ssd ? pin(17)[l * 768 + ch + e] : 0.f;
    u32x4 h[3];
#pragma unroll
    for (int i = 0; i < 3; ++i) h[i] = (u32x4){0, 0, 0, 0};
    const int row0 = kind == 0 ? unit * 32 : TP + unit * 4;
    if (kind == 0) { if ((row0 % SEQ) != 0) {
#pragma unroll
            for (int i = 0; i < 3; ++i) h[i] = *(const u32x4*)(proj + (size_t)(row0 - 3 + i) * PN + col); } }
    else if (kind == 1) { const float* st = (ssd ? pin(7) : pin(4)) + (size_t)((l * NSB + unit) * 3) * 768 + ch;
#pragma unroll
        for (int i = 0; i < 3; ++i) { const f32x4 a = *(const f32x4*)(st + i * 768), b = *(const f32x4*)(st + i * 768 + 4);
            h[i] = (u32x4){pkh(a[0], a[1]), pkh(a[2], a[3]), pkh(b[0], b[1]), pkh(b[2], b[3])}; } }
    xcd_barrier(xbar);
    if (kind == 0) {
#pragma unroll 1
        for (int hb = 1; hb >= 0; --hb) {
            const int r = row0 + 16 * hb;
            u32x4 cur[16], pre[3];
#pragma unroll
            for (int i = 0; i < 16; ++i) cur[i] = *(const u32x4*)(proj + (size_t)(r + i) * PN + col);
#pragma unroll
            for (int i = 0; i < 3; ++i) { pre[i] = h[i]; if (hb) pre[i] = *(const u32x4*)(proj + (size_t)(r - 3 + i) * PN + col); }
            if (hb && ((row0 + 32) % SEQ) == 0) {
                float* so = pout() + (ssd ? O_SSDC_P : O_GDNC_P) + (size_t)((l * NB + row0 / SEQ) * 3) * 768 + ch;
#pragma unroll
                for (int i = 0; i < 3; ++i) { float t[8]; u4f(cur[13 + i], t);
                    *(f32x4*)(so + i * 768) = (f32x4){t[0], t[1], t[2], t[3]}; *(f32x4*)(so + i * 768 + 4) = (f32x4){t[4], t[5], t[6], t[7]}; }
            }
            float w0[8], w1[8], w2[8];
            u4f(pre[0], w0); u4f(pre[1], w1); u4f(pre[2], w2);
#pragma unroll
            for (int i = 0; i < 16; ++i) { float w3[8], o[8]; u4f(cur[i], w3);
#pragma unroll
                for (int e = 0; e < 8; ++e) { const float a = bias[e] + w[0][e] * w0[e] + w[1][e] * w1[e] + w[2][e] * w2[e] + w[3][e] * w3[e]; o[e] = siluf_(a); w0[e] = w1[e]; w1[e] = w2[e]; w2[e] = w3[e]; }
                *(u32x4*)(proj + (size_t)(r + i) * PN + col) = (u32x4){pkh(o[0], o[1]), pkh(o[2], o[3]), pkh(o[4], o[5]), pkh(o[6], o[7])}; }
        }
    } else if (kind == 1) {
        u32x4 cur[4];
#pragma unroll
        for (int i = 0; i < 4; ++i) cur[i] = *(const u32x4*)(proj + (size_t)(row0 + i) * PN + col);
        float win[7][8];
#pragma unroll
        for (int i = 0; i < 3; ++i) u4f(h[i], win[i]);
#pragma unroll
        for (int i = 0; i < 4; ++i) u4f(cur[i], win[3 + i]);
        float* so = pout() + (ssd ? O_SSDC_S : O_GDNC_S) + (size_t)((l * NSB + unit) * 3) * 768 + ch;
#pragma unroll
        for (int i = 0; i < 3; ++i) { *(f32x4*)(so + i * 768) = (f32x4){win[4 + i][0], win[4 + i][1], win[4 + i][2], win[4 + i][3]};
            *(f32x4*)(so + i * 768 + 4) = (f32x4){win[4 + i][4], win[4 + i][5], win[4 + i][6], win[4 + i][7]}; }
#pragma unroll
        for (int i = 0; i < 4; ++i) { float o[8];
#pragma unroll
            for (int e = 0; e < 8; ++e) { float a = bias[e];
#pragma unroll
                for (int j = 0; j < 4; ++j) a += w[j][e] * win[i + j][e];
                o[e] = siluf_(a); }
            *(u32x4*)(proj + (size_t)(row0 + i) * PN + col) = (u32x4){pkh(o[0], o[1]), pkh(o[2], o[3]), pkh(o[4], o[5]), pkh(o[6], o[7])}; }
    }
}

template <int MIX> struct RecCfg { static constexpr int K = (MIX == 3 ? 128 : 64), KPL = K / 16, KS = (MIX == 3 ? 132 : 64);
    static constexpr int OFF_Q = 0, OFF_K = 64 * KS, OFF_F = 2 * 64 * KS, OFF_V = (MIX == 0 ? 3 : 2) * 64 * KS, OFF_XSD = OFF_V + 2048, OFF_SC = OFF_XSD + 2048, OFF_O = OFF_SC + 256; };

template <int MIX> struct Raw;
template <> struct Raw<0> { u32x4 hq, hf; u32x2 hi; };
template <> struct Raw<1> { u32x4 q, k; u32x2 v; float ga, gb; };
template <> struct Raw<2> { u32x2 q1, q2, k1, k2, v; };
template <> struct Raw<3> { u32x4 b[2], c[2]; u32x2 x; float dt; };

struct Slot { int row, pos, seq; };

template <bool SAMPLE> __device__ __forceinline__ Slot slot_of(int chunk, int s, int sg) {
    Slot r;
    if (SAMPLE) { r.seq = sg * 16 + (s >> 2); r.pos = s & 3; r.row = TP + r.seq * 4 + r.pos; }
    else { r.seq = 0; r.pos = chunk * 64 + s; r.row = sg * SEQ + r.pos; }
    return r;
}

template <int MIX, bool SAMPLE>
__device__ __forceinline__ void rec_load(Raw<MIX>& R, const f16_t* proj, int chunk, int sg, int head, int vcol0) {
    const int tid = tidx(), s = tid >> 3, cgi = tid & 7;
    const Slot sl = slot_of<SAMPLE>(chunk, s, sg);
    const f16_t* rowp = proj + (size_t)sl.row * PN;
    if constexpr (MIX == 0) {
        R.hq = *(const u32x4*)(rowp + C_HQ + head * 64 + cgi * 8);
        R.hf = *(const u32x4*)(rowp + C_HF + head * 64 + cgi * 8);
        R.hi = *(const u32x2*)(rowp + C_HI + head * 64 + vcol0 + cgi * 4);
    } else if constexpr (MIX == 1) {
        R.q = *(const u32x4*)(rowp + C_GQKV + head * 64 + cgi * 8);
        R.k = *(const u32x4*)(rowp + C_GQKV + 256 + head * 64 + cgi * 8);
        R.v = *(const u32x2*)(rowp + C_GQKV + 512 + head * 64 + vcol0 + cgi * 4);
        R.ga = hload(rowp + C_GA + head); R.gb = hload(rowp + C_GB + head);
    } else if constexpr (MIX == 2) {
        R.q1 = *(const u32x2*)(rowp + C_RQ + head * 64 + cgi * 4); R.q2 = *(const u32x2*)(rowp + C_RQ + head * 64 + 32 + cgi * 4);
        R.k1 = *(const u32x2*)(rowp + C_RK + head * 64 + cgi * 4); R.k2 = *(const u32x2*)(rowp + C_RK + head * 64 + 32 + cgi * 4);
        R.v = *(const u32x2*)(rowp + C_RV + head * 64 + vcol0 + cgi * 4);
    } else {
        const f16_t* pb = rowp + C_SXBC + 256 + (head >> 1) * 128 + cgi * 16;
        R.b[0] = *(const u32x4*)pb; R.b[1] = *(const u32x4*)(pb + 8); R.c[0] = *(const u32x4*)(pb + 256); R.c[1] = *(const u32x4*)(pb + 264);
        R.x = *(const u32x2*)(rowp + C_SXBC + head * 64 + vcol0 + cgi * 4);
        R.dt = hload(rowp + C_SDT + head);
    }
}

struct MixPar { float f[8]; };
template <int MIX> __device__ __forceinline__ MixPar mix_par(int l, int head) {
    MixPar m; const int cgi = tidx() & 7;
#pragma unroll
    for (int i = 0; i < 8; ++i) m.f[i] = 0.f;
    if constexpr (MIX == 0) {
#pragma unroll
        for (int i = 0; i < 8; ++i) { const int c = head * 64 + cgi * 8 + i; m.f[i] = l == 0 ? 0.f : sigmoidf_(pin(10)[256 + c] - pin(10)[c]); }
    } else if constexpr (MIX == 1) { m.f[0] = expf(pin(13)[l * 4 + head]); m.f[1] = pin(14)[l * 4 + head]; }
    else if constexpr (MIX == 2) {
#pragma unroll
        for (int i = 0; i < 4; ++i) m.f[i] = powf(10000.0f, -(float)(cgi * 4 + i) * (1.0f / 32.0f));
        m.f[4] = log2f(1.0f - exp2f(-5.0f - (float)head));
    } else { m.f[0] = pin(18)[l * 4 + head]; m.f[1] = expf(pin(19)[l * 4 + head]); m.f[2] = pin(20)[l * 4 + head]; }
    return m;
}

template <int MIX, bool SAMPLE>
__device__ __forceinline__ void rec_process(const Raw<MIX>& R, const MixPar& par, int l, LAS float* L, int chunk, int sg, int head) {
    typedef RecCfg<MIX> C;
    const int tid = tidx(), s = tid >> 3, cgi = tid & 7;
    const Slot sl = slot_of<SAMPLE>(chunk, s, sg);
    if constexpr (MIX == 0) {
        float hq[8], hf[8], hi[4]; u4f(R.hq, hq); u4f(R.hf, hf); u2f(R.hi, hi);
        float q[8], k[8], f[8];
#pragma unroll
        for (int i = 0; i < 8; ++i) { const int c = head * 64 + cgi * 8 + i;
            const float lb = par.f[i];
            const float sg_ = sigmoidf_(hf[i]);
            q[i] = sigmoidf_(hq[i]); f[i] = lb + (1.f - lb) * sg_; k[i] = (1.f - lb) * (1.f - sg_); }
        *(LAS f32x4*)(L + C::OFF_Q + s * 64 + cgi * 8) = (f32x4){q[0], q[1], q[2], q[3]}; *(LAS f32x4*)(L + C::OFF_Q + s * 64 + cgi * 8 + 4) = (f32x4){q[4], q[5], q[6], q[7]};
        *(LAS f32x4*)(L + C::OFF_K + s * 64 + cgi * 8) = (f32x4){k[0], k[1], k[2], k[3]}; *(LAS f32x4*)(L + C::OFF_K + s * 64 + cgi * 8 + 4) = (f32x4){k[4], k[5], k[6], k[7]};
        *(LAS f32x4*)(L + C::OFF_F + s * 64 + cgi * 8) = (f32x4){f[0], f[1], f[2], f[3]}; *(LAS f32x4*)(L + C::OFF_F + s * 64 + cgi * 8 + 4) = (f32x4){f[4], f[5], f[6], f[7]};
        *(LAS f32x4*)(L + C::OFF_V + s * 32 + cgi * 4) = (f32x4){hi[0], hi[1], hi[2], hi[3]};
    } else if constexpr (MIX == 1) {
        float q[8], k[8], v[4]; u4f(R.q, q); u4f(R.k, k); u2f(R.v, v);
        float sq = 0.f, sk = 0.f;
#pragma unroll
        for (int i = 0; i < 8; ++i) { sq += q[i] * q[i]; sk += k[i] * k[i]; }
        sq = red8(sq); sk = red8(sk);
        const float rq = rsqrtf(sq + EPS) * 0.125f, rk = rsqrtf(sk + EPS);
        float kq = 0.f;
#pragma unroll
        for (int i = 0; i < 8; ++i) { q[i] *= rq; k[i] *= rk; kq += q[i] * k[i]; }
        kq = red8(kq);
        *(LAS f32x4*)(L + C::OFF_Q + s * 64 + cgi * 8) = (f32x4){q[0], q[1], q[2], q[3]}; *(LAS f32x4*)(L + C::OFF_Q + s * 64 + cgi * 8 + 4) = (f32x4){q[4], q[5], q[6], q[7]};
        *(LAS f32x4*)(L + C::OFF_K + s * 64 + cgi * 8) = (f32x4){k[0], k[1], k[2], k[3]}; *(LAS f32x4*)(L + C::OFF_K + s * 64 + cgi * 8 + 4) = (f32x4){k[4], k[5], k[6], k[7]};
        *(LAS f32x4*)(L + C::OFF_V + s * 32 + cgi * 4) = (f32x4){v[0], v[1], v[2], v[3]};
        if (cgi == 0) { const float a = expf(-par.f[0] * softplusf_(R.ga + par.f[1]));
            *(LAS f32x4*)(L + C::OFF_SC + s * 4) = (f32x4){a, sigmoidf_(R.gb), kq, 0.f}; }
    } else if constexpr (MIX == 2) {
        float q1[4], q2[4], k1[4], k2[4], v[4]; u2f(R.q1, q1); u2f(R.q2, q2); u2f(R.k1, k1); u2f(R.k2, k2); u2f(R.v, v);
        const float posf = (float)(SAMPLE ? PASTLEN + sl.pos : sl.pos);
        float qa[4], qb[4], ka[4], kb[4];
#pragma unroll
        for (int i = 0; i < 4; ++i) { const int fi = cgi * 4 + i;
            const float invf = par.f[i];
            const float ang = posf * invf;
            double rev = (double)ang * 0.15915494309189535; rev -= floor(rev);
            const float sn = __builtin_amdgcn_sinf((float)rev), cs = __builtin_amdgcn_cosf((float)rev);
            qa[i] = q1[i] * cs - q2[i] * sn; qb[i] = q1[i] * sn + q2[i] * cs;
            ka[i] = (k1[i] * cs - k2[i] * sn) * 0.125f; kb[i] = (k1[i] * sn + k2[i] * cs) * 0.125f; }
        *(LAS f32x4*)(L + C::OFF_Q + s * 64 + cgi * 4) = (f32x4){qa[0], qa[1], qa[2], qa[3]}; *(LAS f32x4*)(L + C::OFF_Q + s * 64 + 32 + cgi * 4) = (f32x4){qb[0], qb[1], qb[2], qb[3]};
        *(LAS f32x4*)(L + C::OFF_K + s * 64 + cgi * 4) = (f32x4){ka[0], ka[1], ka[2], ka[3]}; *(LAS f32x4*)(L + C::OFF_K + s * 64 + 32 + cgi * 4) = (f32x4){kb[0], kb[1], kb[2], kb[3]};
        *(LAS f32x4*)(L + C::OFF_V + s * 32 + cgi * 4) = (f32x4){v[0], v[1], v[2], v[3]};
        if (cgi == 0) *(LAS f32x4*)(L + C::OFF_SC + s * 4) = (f32x4){exp2f(par.f[4]), 0.f, 0.f, 0.f};
    } else {
        float b0[8], b1[8], c0[8], c1[8], x[4]; u4f(R.b[0], b0); u4f(R.b[1], b1); u4f(R.c[0], c0); u4f(R.c[1], c1); u2f(R.x, x);
        const float dt = softplusf_(R.dt + par.f[0]);
        const float a = expf(-par.f[1] * dt), dsk = par.f[2];
        LAS float* qd = L + C::OFF_Q + s * C::KS + cgi * 16 + 4 * (cgi >> 2); LAS float* kd = L + C::OFF_K + s * C::KS + cgi * 16 + 4 * (cgi >> 2);
        *(LAS f32x4*)(qd) = (f32x4){c0[0], c0[1], c0[2], c0[3]}; *(LAS f32x4*)(qd + 4) = (f32x4){c0[4], c0[5], c0[6], c0[7]};
        *(LAS f32x4*)(qd + 8) = (f32x4){c1[0], c1[1], c1[2], c1[3]}; *(LAS f32x4*)(qd + 12) = (f32x4){c1[4], c1[5], c1[6], c1[7]};
        *(LAS f32x4*)(kd) = (f32x4){b0[0], b0[1], b0[2], b0[3]}; *(LAS f32x4*)(kd + 4) = (f32x4){b0[4], b0[5], b0[6], b0[7]};
        *(LAS f32x4*)(kd + 8) = (f32x4){b1[0], b1[1], b1[2], b1[3]}; *(LAS f32x4*)(kd + 12) = (f32x4){b1[4], b1[5], b1[6], b1[7]};
        *(LAS f32x4*)(L + C::OFF_V + s * 32 + cgi * 4) = (f32x4){x[0] * dt, x[1] * dt, x[2] * dt, x[3] * dt};
        *(LAS f32x4*)(L + C::OFF_XSD + s * 32 + cgi * 4) = (f32x4){x[0] * dsk, x[1] * dsk, x[2] * dsk, x[3] * dsk};
        if (cgi == 0) *(LAS f32x4*)(L + C::OFF_SC + s * 4) = (f32x4){a, 0.f, 0.f, 0.f};
    }
}

template <int MIX, bool REDUCE = true>
__device__ __forceinline__ float rec_step(float (&S)[RecCfg<MIX>::KPL], const LAS float* L, int s, int kg, int vl) {
    typedef RecCfg<MIX> C; constexpr int KPL = C::KPL;
    float q[KPL], k[KPL];
#pragma unroll
    for (int i = 0; i < KPL / 4; ++i) { const int ko = kg * KPL + (MIX == 3 ? 4 * (kg >> 3) : 0) + 4 * i;
        const f32x4 t = *(const LAS f32x4*)(L + C::OFF_Q + s * C::KS + ko);
        q[4 * i] = t[0]; q[4 * i + 1] = t[1]; q[4 * i + 2] = t[2]; q[4 * i + 3] = t[3];
        if constexpr (MIX != 0) { const f32x4 u = *(const LAS f32x4*)(L + C::OFF_K + s * C::KS + ko); k[4 * i] = u[0]; k[4 * i + 1] = u[1]; k[4 * i + 2] = u[2]; k[4 * i + 3] = u[3]; } }
    const float v = L[C::OFF_V + s * 32 + vl];
    float o;
    if constexpr (MIX == 0) {
        const f32x4 f = *(const LAS f32x4*)(L + C::OFF_F + s * 64 + kg * 4);
        const f32x2 vv = (f32x2){v, v};
        f32x2 s0 = (f32x2){S[0], S[1]}, s1 = (f32x2){S[2], S[3]};
        s0 = (f32x2){f[0], f[1]} * (s0 - vv) + vv; s1 = (f32x2){f[2], f[3]} * (s1 - vv) + vv;
        f32x2 p2 = s0 * (f32x2){q[0], q[1]}; p2 = s1 * (f32x2){q[2], q[3]} + p2;
        S[0] = s0.x; S[1] = s0.y; S[2] = s1.x; S[3] = s1.y;
        const float op = p2.x + p2.y;
        o = REDUCE ? red16(op) : op;
    } else if constexpr (MIX == 1) {
        const f32x4 sc = *(const LAS f32x4*)(L + C::OFF_SC + s * 4);
        f32x2 s0 = (f32x2){S[0], S[1]}, s1 = (f32x2){S[2], S[3]};
        const f32x2 k0 = (f32x2){k[0], k[1]}, k1 = (f32x2){k[2], k[3]};
        f32x2 r2 = s0 * k0; r2 = s1 * k1 + r2;
        f32x2 p2 = s0 * (f32x2){q[0], q[1]}; p2 = s1 * (f32x2){q[2], q[3]} + p2;
        float r = r2.x + r2.y; const float pq = p2.x + p2.y;
        r = red16(r);
        const float u = sc[1] * (v - sc[0] * r);
        const f32x2 uu = (f32x2){u, u}, aa = (f32x2){sc[0], sc[0]};
        s0 = s0 * aa + k0 * uu; s1 = s1 * aa + k1 * uu;
        S[0] = s0.x; S[1] = s0.y; S[2] = s1.x; S[3] = s1.y;
        if (REDUCE) o = sc[0] * red16(pq) + sc[2] * u;
        else o = sc[0] * pq + (kg == 0 ? sc[2] * u : 0.f);
    } else {
        const float a = L[C::OFF_SC + s * 4];
        float op = 0.f;
#pragma unroll
        for (int i = 0; i < KPL; ++i) { S[i] = a * S[i] + k[i] * v; op += S[i] * q[i]; }
        o = REDUCE ? red16(op) : op;
    }
    return o;
}

__device__ __forceinline__ void gdn_group8(float (&S)[4], float (&pp)[16], int j0, const LAS float* L, int sbase_, int kg, int vl) {
    typedef RecCfg<1> C;
    f32x4 q[8], k[8]; f32x2 sc[8]; float v[8];
#pragma unroll
    for (int j = 0; j < 8; ++j) { const int s = sbase_ + j;
        q[j] = *(const LAS f32x4*)(L + C::OFF_Q + s * 64 + kg * 4); k[j] = *(const LAS f32x4*)(L + C::OFF_K + s * 64 + kg * 4);
        sc[j] = *(const LAS f32x2*)(L + C::OFF_SC + s * 4); v[j] = L[C::OFF_V + s * 32 + vl]; }
    __builtin_amdgcn_sched_barrier(0);
    f32x2 s0 = (f32x2){S[0], S[1]}, s1 = (f32x2){S[2], S[3]};
#pragma unroll
    for (int j = 0; j < 8; ++j) {
        const f32x2 k0 = (f32x2){k[j][0], k[j][1]}, k1 = (f32x2){k[j][2], k[j][3]};
        f32x2 r2 = s0 * k0; r2 = s1 * k1 + r2;
        const float r = red16(r2.x + r2.y);
        const float u = sc[j][1] * (v[j] - sc[j][0] * r);
        const f32x2 uu = (f32x2){u, u}, aa = (f32x2){sc[j][0], sc[j][0]};
        s0 = s0 * aa + k0 * uu; s1 = s1 * aa + k1 * uu;
        f32x2 p2 = s0 * (f32x2){q[j][0], q[j][1]}; p2 = s1 * (f32x2){q[j][2], q[j][3]} + p2;
        pp[j0 + j] = p2.x + p2.y;
    }
    S[0] = s0.x; S[1] = s0.y; S[2] = s1.x; S[3] = s1.y;
}

__device__ __forceinline__ void hgrn_group8(float (&S)[4], float (&pp)[16], int j0, const LAS float* L, int sbase_, int kg, int vl) {
    typedef RecCfg<0> C;
    f32x4 q[8], f[8]; float v[8];
#pragma unroll
    for (int j = 0; j < 8; ++j) { const int s = sbase_ + j;
        q[j] = *(const LAS f32x4*)(L + C::OFF_Q + s * 64 + kg * 4); f[j] = *(const LAS f32x4*)(L + C::OFF_F + s * 64 + kg * 4);
        v[j] = L[C::OFF_V + s * 32 + vl]; }
    __builtin_amdgcn_sched_barrier(0);
    f32x2 s0 = (f32x2){S[0], S[1]}, s1 = (f32x2){S[2], S[3]};
#pragma unroll
    for (int j = 0; j < 8; ++j) {
        const f32x2 vv = (f32x2){v[j], v[j]};
        s0 = (f32x2){f[j][0], f[j][1]} * (s0 - vv) + vv; s1 = (f32x2){f[j][2], f[j][3]} * (s1 - vv) + vv;
        f32x2 p2 = s0 * (f32x2){q[j][0], q[j][1]}; p2 = s1 * (f32x2){q[j][2], q[j][3]} + p2;
        pp[j0 + j] = p2.x + p2.y;
    }
    S[0] = s0.x; S[1] = s0.y; S[2] = s1.x; S[3] = s1.y;
}

__device__ __forceinline__ float reduce_scatter16(const float (&p)[16], int kg) {
    const bool b3 = kg & 8, b2 = kg & 4, b1 = kg & 2, b0 = kg & 1;
    float t[8], u[4], w[2];
#pragma unroll
    for (int j = 0; j < 8; ++j) { const float keep = b3 ? p[j + 8] : p[j], send = b3 ? p[j] : p[j + 8]; t[j] = keep + dppf<0x140>(send); }
#pragma unroll
    for (int j = 0; j < 4; ++j) { const float keep = b2 ? t[j + 4] : t[j], send = b2 ? t[j] : t[j + 4]; u[j] = keep + dppf<0x141>(send); }
#pragma unroll
    for (int j = 0; j < 2; ++j) { const float keep = b1 ? u[j + 2] : u[j], send = b1 ? u[j] : u[j + 2]; w[j] = keep + dppf<0x1B>(send); }
    const float keep = b0 ? w[1] : w[0], send = b0 ? w[0] : w[1];
    return keep + dppf<0xB1>(send);
}

template <int MIX, bool SAMPLE>
__device__ __forceinline__ void rec_store_o(const LAS float* L, f16_t* raw, int chunk, int sg, int mixer, int head, int vcol0, int nv = 32) {
    typedef RecCfg<MIX> C;
    const int tid = tidx(), s = tid >> 3, c4 = (tid & 7) * 4;
    const Slot sl = slot_of<SAMPLE>(chunk, s, sg);
    f32x4 o = *(const LAS f32x4*)(L + C::OFF_O + s * 32 + c4);
    if constexpr (MIX == 3) o = o + *(const LAS f32x4*)(L + C::OFF_XSD + s * 32 + c4);
    u32x2 w; w.x = pkh(o[0], o[1]); w.y = pkh(o[2], o[3]);
    if (c4 < nv) *(u32x2*)(raw + (size_t)sl.row * DM + mixer * 256 + head * 64 + vcol0 + c4) = w;
}

template <int MIX, bool DO_PROMPT, bool DO_SAMPLE>
__device__ __forceinline__ void rec_unit(const Params& p, int l, LAS unsigned char* lds, int sg, int head, int vcol0, int nv = 32) {
    typedef RecCfg<MIX> C; constexpr int KPL = C::KPL, K = C::K;
    LAS float* L = (LAS float*)lds;
    const f16_t* proj = (const f16_t*)(pws() + WS_PROJ);
    f16_t* raw = (f16_t*)(pws() + WS_XN);
    const int tid = tidx(), w = tid >> 6, lane = tid & 63, kg = lane & 15, vi = lane >> 4, vl = w * 4 + vi, vcol = vcol0 + vl; const bool act = w * 4 < nv;
    constexpr int sidx = MIX == 0 ? 2 : MIX == 1 ? 3 : MIX == 2 ? 5 : 6;
    constexpr long o_p = MIX == 0 ? O_HGRN_P : MIX == 1 ? O_GDN_P : MIX == 2 ? O_RET_P : O_SSD_P;
    constexpr long o_s = MIX == 0 ? O_HGRN_S : MIX == 1 ? O_GDN_S : MIX == 2 ? O_RET_S : O_SSD_S;
    Raw<MIX> R;
    const MixPar par = mix_par<MIX>(l, head);
    float S[KPL];
#pragma unroll
    for (int i = 0; i < KPL; ++i) S[i] = 0.f;
    if constexpr (DO_PROMPT) {
    if constexpr (MIX == 1) {
        constexpr int BUF = C::OFF_O + 2048;
        rec_load<MIX, false>(R, proj, 0, sg, head, vcol0);
        rec_process<MIX, false>(R, par, l, L, 0, sg, head);
        __syncthreads();
        rec_load<MIX, false>(R, proj, 1, sg, head, vcol0);
#pragma unroll 1
        for (int c = 0; c < SEQ / 64; ++c) {
            LAS float* Lc = L + (c & 1) * BUF;
#pragma unroll 1
            for (int g = 0; g < (act ? 4 : 0); ++g) { float pp[16];
                gdn_group8(S, pp, 0, Lc, g * 16, kg, vl); gdn_group8(S, pp, 8, Lc, g * 16 + 8, kg, vl);
                Lc[C::OFF_O + (g * 16 + kg) * 32 + vl] = reduce_scatter16(pp, kg); }
            if (c + 1 < SEQ / 64) { rec_process<MIX, false>(R, par, l, L + ((c + 1) & 1) * BUF, c + 1, sg, head);
                if (c + 2 < SEQ / 64) rec_load<MIX, false>(R, proj, c + 2, sg, head, vcol0);
                else if (DO_SAMPLE) rec_load<MIX, true>(R, proj, 0, sg, head, vcol0); }
            __syncthreads();
            rec_store_o<MIX, false>(Lc, raw, c, sg, MIX, head, vcol0, nv);
        }
        __syncthreads();
    } else {
    rec_load<MIX, false>(R, proj, 0, sg, head, vcol0);
#pragma unroll 1
    for (int c = 0; c < SEQ / 64; ++c) {
        rec_process<MIX, false>(R, par, l, L, c, sg, head);
        __syncthreads();
        if (c + 1 < SEQ / 64) rec_load<MIX, false>(R, proj, c + 1, sg, head, vcol0);
        else if (DO_SAMPLE) rec_load<MIX, true>(R, proj, 0, sg, head, vcol0);
#pragma unroll 1
        for (int g = 0; g < (act ? 4 : 0); ++g) { float oacc = 0.f;
            { float pp[16];
              if constexpr (MIX == 0) { hgrn_group8(S, pp, 0, L, g * 16, kg, vl); hgrn_group8(S, pp, 8, L, g * 16 + 8, kg, vl); }
              else {
#pragma unroll
                  for (int j = 0; j < 16; ++j) pp[j] = rec_step<MIX, false>(S, L, g * 16 + j, kg, vl);
              }
              oacc = reduce_scatter16(pp, kg); }
            L[C::OFF_O + (g * 16 + kg) * 32 + vl] = oacc; }
        __syncthreads();
        rec_store_o<MIX, false>(L, raw, c, sg, MIX, head, vcol0, nv);
    }
    }
    if (act) { float* so = pout() + o_p + ((size_t)(l * NB + sg) * 4 + head) * K * 64;
#pragma unroll
      for (int i = 0; i < KPL; ++i) so[(kg * KPL + i) * 64 + vcol] = S[i]; }
    }
    if constexpr (!DO_SAMPLE) return;
    if constexpr (!DO_PROMPT) rec_load<MIX, true>(R, proj, 0, sg, head, vcol0);
    rec_process<MIX, true>(R, par, l, L, 0, sg, head);
    __syncthreads();
    const float* sbase = p.in[sidx] + ((size_t)(l * NSB + sg * 16) * 4 + head) * K * 64;
    float* obase = pout() + o_s + ((size_t)(l * NSB + sg * 16) * 4 + head) * K * 64;
    float Sn[KPL], Sm[KPL];
#pragma unroll
    for (int i = 0; i < KPL; ++i) { Sn[i] = 0.f; Sm[i] = 0.f; if (act) { Sn[i] = sbase[(kg * KPL + i) * 64 + vcol]; Sm[i] = sbase[(size_t)4 * K * 64 + (kg * KPL + i) * 64 + vcol]; } }
#pragma unroll 1
    for (int g = 0; g < (act ? 4 : 0); ++g) { float oacc = 0.f;
#pragma unroll
        for (int qq = 0; qq < 4; ++qq) { const int q = g * 4 + qq;
#pragma unroll
            for (int i = 0; i < KPL; ++i) { S[i] = Sn[i]; Sn[i] = Sm[i]; }
            if (q + 2 < 16) {
#pragma unroll
                for (int i = 0; i < KPL; ++i) Sm[i] = sbase[(size_t)(q + 2) * 4 * K * 64 + (kg * KPL + i) * 64 + vcol]; }
#pragma unroll
            for (int t = 0; t < 4; ++t) { const float o = rec_step<MIX>(S, L, q * 4 + t, kg, vl); oacc = (kg == qq * 4 + t) ? o : oacc; }
#pragma unroll
            for (int i = 0; i < KPL; ++i) obase[(size_t)q * 4 * K * 64 + (kg * KPL + i) * 64 + vcol] = S[i];
        }
        L[C::OFF_O + (g * 16 + kg) * 32 + vl] = oacc; }
    __syncthreads();
    rec_store_o<MIX, true>(L, raw, 0, sg, MIX, head, vcol0, nv);
    __syncthreads();
}

template <int MIX> struct ChCfg { static constexpr int K = (MIX == 3 ? 128 : 64), RS = 2 * K + 16  , TS_ = 144  ,
    B_QH = 0, B_KH = 64 * RS, B_QT = 2 * 64 * RS, B_KT = 3 * 64 * RS, B_VT = B_KT + K * TS_, B_G = B_VT + 32 * TS_, B_END = B_G + 512; };
static_assert(128 * 132 == TT, "deferred residual copy must cover all rows");
static_assert(N_TILES_WIN0 + 64 * (40 + 35 + 14) == N_TILES_ALL, "deferred weight tiles must cover all remaining tiles");
static_assert(ChCfg<2>::B_END <= RecCfg<2>::OFF_O * 4 && ChCfg<3>::B_END <= RecCfg<3>::OFF_XSD * 4, "chunk images must end below the O / XSD tables");

template <int MIX>
__device__ __forceinline__ void ch_process(const Raw<MIX>& R, const MixPar& par, LAS unsigned char* B, int chunk) {
    typedef ChCfg<MIX> C; typedef RecCfg<MIX> RC;
    const int tid = tidx(), s = tid >> 3, cgi = tid & 7, pm = s & 15;
    LAS float* Gt = (LAS float*)(B + C::B_G);
    LAS float* Lf = (LAS float*)B;
    if constexpr (MIX == 2) {
        float q1[4], q2[4], k1[4], k2[4], v[4]; u2f(R.q1, q1); u2f(R.q2, q2); u2f(R.k1, k1); u2f(R.k2, k2); u2f(R.v, v);
        const float posf = (float)(chunk * 64 + s);
        const float lg = par.f[4];
        const float eg = exp2f(lg * (float)(pm + 1)), ew = exp2f(lg * (float)(15 - pm));
        float qv[8], kv[8];
#pragma unroll
        for (int i = 0; i < 4; ++i) { const int fi = cgi * 4 + i;
            const float invf = par.f[i];
            const float ang = posf * invf;
            double rev = (double)ang * 0.15915494309189535; rev -= floor(rev);
            const float sn = __builtin_amdgcn_sinf((float)rev), cs = __builtin_amdgcn_cosf((float)rev);
            qv[i] = q1[i] * cs - q2[i] * sn; qv[4 + i] = q1[i] * sn + q2[i] * cs;
            kv[i] = (k1[i] * cs - k2[i] * sn) * 0.125f; kv[4 + i] = (k1[i] * sn + k2[i] * cs) * 0.125f; }
#pragma unroll
        for (int hh = 0; hh < 2; ++hh) { const int c0 = hh * 32 + cgi * 4;
            *(LAS u32x2*)(B + C::B_QH + s * C::RS + c0 * 2) = (u32x2){pkh(qv[4 * hh], qv[4 * hh + 1]), pkh(qv[4 * hh + 2], qv[4 * hh + 3])};
            *(LAS u32x2*)(B + C::B_KH + s * C::RS + c0 * 2) = (u32x2){pkh(kv[4 * hh], kv[4 * hh + 1]), pkh(kv[4 * hh + 2], kv[4 * hh + 3])};
            *(LAS u32x2*)(B + C::B_QT + s * C::RS + c0 * 2) = (u32x2){pkh(qv[4 * hh] * eg, qv[4 * hh + 1] * eg), pkh(qv[4 * hh + 2] * eg, qv[4 * hh + 3] * eg)};
#pragma unroll
            for (int i = 0; i < 4; ++i) *(LAS f16_t*)(B + C::B_KT + (c0 + i) * C::TS_ + s * 2) = (f16_t)(kv[4 * hh + i] * ew); }
#pragma unroll
        for (int i = 0; i < 4; ++i) *(LAS f16_t*)(B + C::B_VT + (cgi * 4 + i) * C::TS_ + s * 2) = (f16_t)v[i];
        if (cgi == 0) Gt[s] = 0.6931471806f * lg * (float)(pm + 1);
    } else {
        float b0[8], b1[8], c0[8], c1[8], x[4]; u4f(R.b[0], b0); u4f(R.b[1], b1); u4f(R.c[0], c0); u4f(R.c[1], c1); u2f(R.x, x);
        const float dt = softplusf_(R.dt + par.f[0]);
        const float la = -par.f[1] * dt, dsk = par.f[2];
        LAS float* La = Gt + 64;
        if (cgi == 0) La[s] = la;
        __syncthreads();
        float g = 0.f, ge = 0.f;
#pragma unroll
        for (int j = 0; j < 16; ++j) { const float t = La[(s & ~15) + j]; ge += t; g += (j <= pm) ? t : 0.f; }
        const float eg = expf(g), ew = expf(ge - g);
        float bb[16], cc[16];
#pragma unroll
        for (int i = 0; i < 8; ++i) { bb[i] = b0[i]; bb[8 + i] = b1[i]; cc[i] = c0[i]; cc[8 + i] = c1[i]; }
#pragma unroll
        for (int i = 0; i < 4; ++i) { const int cc0 = cgi * 16 + 4 * i;
            *(LAS u32x2*)(B + C::B_QH + s * C::RS + cc0 * 2) = (u32x2){pkh(cc[4 * i], cc[4 * i + 1]), pkh(cc[4 * i + 2], cc[4 * i + 3])};
            *(LAS u32x2*)(B + C::B_KH + s * C::RS + cc0 * 2) = (u32x2){pkh(bb[4 * i], bb[4 * i + 1]), pkh(bb[4 * i + 2], bb[4 * i + 3])};
            *(LAS u32x2*)(B + C::B_QT + s * C::RS + cc0 * 2) = (u32x2){pkh(cc[4 * i] * eg, cc[4 * i + 1] * eg), pkh(cc[4 * i + 2] * eg, cc[4 * i + 3] * eg)};
#pragma unroll
            for (int e = 0; e < 4; ++e) *(LAS f16_t*)(B + C::B_KT + (cc0 + e) * C::TS_ + s * 2) = (f16_t)(bb[4 * i + e] * ew); }
#pragma unroll
        for (int i = 0; i < 4; ++i) *(LAS f16_t*)(B + C::B_VT + (cgi * 4 + i) * C::TS_ + s * 2) = (f16_t)(x[i] * dt);
        *(LAS f32x4*)(Lf + RC::OFF_XSD + s * 32 + cgi * 4) = (f32x4){x[0] * dsk, x[1] * dsk, x[2] * dsk, x[3] * dsk};
        if (cgi == 0) Gt[s] = g;
    }
}

template <int MIX>
__device__ __forceinline__ void ch_scan(f32x4 (&St)[ChCfg<MIX>::K / 16], LAS unsigned char* B, int vg, int lane) {
    typedef ChCfg<MIX> C; typedef RecCfg<MIX> RC; constexpr int K = C::K;
    const int r = lane & 15, h = lane >> 4;
    const LAS float* Gt = (const LAS float*)(B + C::B_G);
    LAS float* Of = (LAS float*)B + RC::OFF_O;
#pragma unroll
    for (int mc = 0; mc < 4; ++mc) {
        const int t0 = mc * 16;
        f32x4 X = (f32x4){0.f, 0.f, 0.f, 0.f};
#pragma unroll
        for (int kb = 0; kb < K / 32; ++kb) {
            const f16x8 a = *(const LAS f16x8*)(B + C::B_KH + (t0 + r) * C::RS + (kb * 32 + 8 * h) * 2);
            const f16x8 b = *(const LAS f16x8*)(B + C::B_QH + (t0 + r) * C::RS + (kb * 32 + 8 * h) * 2);
            X = __builtin_amdgcn_mfma_f32_16x16x32_f16(a, b, X, 0, 0, 0); }
        const float gi = Gt[t0 + r]; const f32x4 gj = *(const LAS f32x4*)(Gt + t0 + 4 * h);
        f16x8 pa, vb;
#pragma unroll
        for (int e = 0; e < 4; ++e) { const float d = fminf(gi - gj[e], 0.f); const float pv = (4 * h + e <= r) ? X[e] * __expf(d) : 0.f; pa[e] = (f16_t)pv; pa[4 + e] = (f16_t)0.f; }
        { const u32x2 vv = *(const LAS u32x2*)(B + C::B_VT + (16 * vg + r) * C::TS_ + (t0 + 4 * h) * 2);
          const u32x4 v4 = (u32x4){vv.x, vv.y, 0u, 0u}; vb = __builtin_bit_cast(f16x8, v4); }
        f32x4 O = __builtin_amdgcn_mfma_f32_16x16x32_f16(pa, vb, (f32x4){0.f, 0.f, 0.f, 0.f}, 0, 0, 0);
#pragma unroll
        for (int m = 0; m < K / 32; ++m) {
            const u32x2 qa0 = *(const LAS u32x2*)(B + C::B_QT + (t0 + r) * C::RS + (32 * m + 4 * h) * 2), qa1 = *(const LAS u32x2*)(B + C::B_QT + (t0 + r) * C::RS + (32 * m + 16 + 4 * h) * 2);
            const u32x4 qa4 = (u32x4){qa0.x, qa0.y, qa1.x, qa1.y};
            const u32x4 sb4 = (u32x4){pkh(St[2 * m][0], St[2 * m][1]), pkh(St[2 * m][2], St[2 * m][3]), pkh(St[2 * m + 1][0], St[2 * m + 1][1]), pkh(St[2 * m + 1][2], St[2 * m + 1][3])};
            O = __builtin_amdgcn_mfma_f32_16x16x32_f16(__builtin_bit_cast(f16x8, qa4), __builtin_bit_cast(f16x8, sb4), O, 0, 0, 0); }
#pragma unroll
        for (int e = 0; e < 4; ++e) Of[(t0 + 4 * h + e) * 32 + 16 * vg + r] = O[e];
        const float ge = __expf(Gt[t0 + 15]);
#pragma unroll
        for (int kt = 0; kt < K / 16; ++kt) {
            const u32x2 ka0 = *(const LAS u32x2*)(B + C::B_KT + (16 * kt + r) * C::TS_ + (t0 + 4 * h) * 2);
            const u32x4 ka4 = (u32x4){ka0.x, ka0.y, 0u, 0u};
            St[kt] = __builtin_amdgcn_mfma_f32_16x16x32_f16(__builtin_bit_cast(f16x8, ka4), vb, St[kt] * ge, 0, 0, 0); }
    }
}

template <int MIX>
__device__ __forceinline__ void rec_unit_chunked(const Params& p, int l, LAS unsigned char* lds, int sg, int head, int vhalf) {
    typedef ChCfg<MIX> C; constexpr int K = C::K;
    const f16_t* proj = (const f16_t*)(pws() + WS_PROJ);
    f16_t* raw = (f16_t*)(pws() + WS_XN);
    const int tid = tidx(), w = __builtin_amdgcn_readfirstlane(tid >> 6), lane = tid & 63;
    constexpr long o_p = MIX == 2 ? O_RET_P : O_SSD_P;
    Raw<MIX> R;
    const MixPar par = mix_par<MIX>(l, head);
    f32x4 St[K / 16];
#pragma unroll
    for (int i = 0; i < K / 16; ++i) St[i] = (f32x4){0.f, 0.f, 0.f, 0.f};
    rec_load<MIX, false>(R, proj, 0, sg, head, vhalf * 32);
#pragma unroll 1
    for (int c = 0; c < SEQ / 64; ++c) {
        ch_process<MIX>(R, par, lds, c);
        __syncthreads();
        if (c + 1 < SEQ / 64) rec_load<MIX, false>(R, proj, c + 1, sg, head, vhalf * 32);
        if (w < 2) ch_scan<MIX>(St, lds, w, lane);
        __syncthreads();
        rec_store_o<MIX, false>((const LAS float*)lds, raw, c, sg, MIX, head, vhalf * 32);
    }
    if (w < 2) { float* so = pout() + o_p + ((size_t)(l * NB + sg) * 4 + head) * K * 64;
        const int r = lane & 15, h = lane >> 4;
#pragma unroll
        for (int kt = 0; kt < K / 16; ++kt)
#pragma unroll
            for (int e = 0; e < 4; ++e) so[(16 * kt + 4 * h + e) * 64 + vhalf * 32 + 16 * w + r] = St[kt][e]; }
    __syncthreads();
}

__device__ __forceinline__ void phase_rec(const Params& p, int l, LAS unsigned char* lds) {
    for (int u = bidx(); u < 256; u += gridDim.x) {
        const int vhalf = u & 1, head = (u >> 1) & 3, mixer = (u >> 3) & 3, sg = u >> 5;
        const int bi = sg * 8 + (u & 7);
        if (mixer == 0) { rec_unit<0, true, false>(p, l, lds, sg, head, vhalf * 32);
            if (l == 0) { convert_tiles(N_TILES_WIN0 + bi * 40, N_TILES_WIN0 + bi * 40 + 40, 1, (LAS float*)lds); copy_x_rows(bi * 132, 132); } }
        else if (mixer == 1) rec_unit<1, true, false>(p, l, lds, sg, head, vhalf * 32);
        else if (mixer == 2) { rec_unit_chunked<2>(p, l, lds, sg, head, vhalf); rec_unit<2, false, true>(p, l, lds, sg, head, vhalf * 32); rec_unit<3, false, true>(p, l, lds, sg, head, vhalf * 32);
            if (l == 0) { convert_tiles(N_TILES_WIN0 + 2560 + bi * 35, N_TILES_WIN0 + 2560 + bi * 35 + 35, 1, (LAS float*)lds); copy_x_rows((64 + bi) * 132, 132); } }
        else { rec_unit_chunked<3>(p, l, lds, sg, head, vhalf); rec_unit<1, false, true>(p, l, lds, sg, head, vhalf * 32); rec_unit<0, false, true>(p, l, lds, sg, head, vhalf * 32);
            if (l == 0) convert_tiles(N_TILES_WIN0 + 4800 + bi * 14, N_TILES_WIN0 + 4800 + bi * 14 + 14, 1, (LAS float*)lds); }
    }
}

__device__ __forceinline__ void phase_post(const Params& p, int l) {
    const int lane = tidx() & 63, gw = bidx() * 8 + (tidx() >> 6), nw = gridDim.x * 8;
    const f16_t* proj = (const f16_t*)(pws() + WS_PROJ);
    f16_t* mix = (f16_t*)(pws() + WS_XN);
    const int c0 = lane * 16, mixer = lane >> 4, cm = c0 & 255;
    const int gcol = mixer == 0 ? C_HG : mixer == 1 ? C_GZ : mixer == 2 ? C_RG : C_SZ;
    float wn[16];
#pragma unroll
    for (int i = 0; i < 16; ++i) wn[i] = mixer == 0 ? pin(11)[l * 64 + ((cm + i) & 63)] : mixer == 1 ? pin(15)[l * 64 + ((cm + i) & 63)] : mixer == 2 ? 1.0f : pin(21)[l * 256 + cm + i];
    for (int r0 = gw; r0 < TT; r0 += 4 * nw) {
        u32x4 ra[4][2], rg[4][2];
#pragma unroll
        for (int bb = 0; bb < 4; ++bb) { const int r = r0 + bb * nw;
            if (r < TT) { const f16_t* mp = mix + (size_t)r * DM + c0; const f16_t* gp = proj + (size_t)r * PN + gcol + cm;
                ra[bb][0] = *(const u32x4*)mp; ra[bb][1] = *(const u32x4*)(mp + 8); rg[bb][0] = *(const u32x4*)gp; rg[bb][1] = *(const u32x4*)(gp + 8); } }
#pragma unroll
        for (int bb = 0; bb < 4; ++bb) { const int r = r0 + bb * nw;
            if (r < TT) {
                f16_t* mp = mix + (size_t)r * DM + c0;
                float x[16], g[16];
                { float t0[8], t1[8]; u4f(ra[bb][0], t0); u4f(ra[bb][1], t1);
#pragma unroll
                  for (int i = 0; i < 8; ++i) { x[i] = t0[i]; x[i + 8] = t1[i]; } }
                { float t0[8], t1[8]; u4f(rg[bb][0], t0); u4f(rg[bb][1], t1);
#pragma unroll
                  for (int i = 0; i < 8; ++i) { g[i] = siluf_(t0[i]); g[i + 8] = siluf_(t1[i]); } }
                float ss = 0.f;
                if (mixer == 3) {
#pragma unroll
                    for (int i = 0; i < 16; ++i) { x[i] *= g[i]; ss += x[i] * x[i]; }
                    ss = red8(ss);
                    const float sc = rsqrtf(ss * (1.0f / 128.0f) + EPS);
#pragma unroll
                    for (int i = 0; i < 16; ++i) x[i] = x[i] * sc * wn[i];
                } else {
#pragma unroll
                    for (int i = 0; i < 16; ++i) ss += x[i] * x[i];
                    ss = red4(ss);
                    const float sc = rsqrtf(ss * (1.0f / 64.0f) + EPS);
#pragma unroll
                    for (int i = 0; i < 16; ++i) x[i] = x[i] * sc * wn[i] * g[i];
                }
                u32x4 a, b; a.x = pkh(x[0], x[1]); a.y = pkh(x[2], x[3]); a.z = pkh(x[4], x[5]); a.w = pkh(x[6], x[7]);
                b.x = pkh(x[8], x[9]); b.y = pkh(x[10], x[11]); b.z = pkh(x[12], x[13]); b.w = pkh(x[14], x[15]);
                *(u32x4*)mp = a; *(u32x4*)(mp + 8) = b;
            } }
    }
}

#ifndef PMASK
#define PMASK 0xFFFFu
#endif
#ifndef RMASK
#define RMASK 0u
#endif
__global__ void __launch_bounds__(512, 2) hymba_fwd(Params p) {
    extern __shared__ __attribute__((aligned(16))) unsigned char shm[];
    LAS unsigned char* lds = (LAS unsigned char*)shm;
    cg::grid_group grid = cg::this_grid();
    volatile LAS unsigned* bst = (volatile LAS unsigned*)(lds + 131072);
    if (tidx() < 2) bst[tidx()] = 0u;
    __syncthreads();
    const XcdBarrier xbar = xcd_barrier_post((unsigned*)(pws() + WS_BAR), bst);
    f16_t* XN = (f16_t*)(pws() + WS_XN);
    f16_t* PROJ = (f16_t*)(pws() + WS_PROJ);
    float* X = pout() + O_Y;
#pragma nounroll
    for (int ph = 0; ph <= 18; ++ph) {
        float* scr = (float*)(pws() + WS_SCR);
        if (ph == 0) { phase_prologue(p, lds); }
        else {
            const int l = (ph - 1) / 9, k = (ph - 1) % 9;
            const f16_t* wt = (const f16_t*)(pws() + WS_WT + l * WT_LAYER);
            if (k == 0 || k == 4 || k == 6 || k == 7) {
                pg8::Gemm g; pg8::EpiAny E; pg8::PowOrder S; S.n17 = 0;
                if (k == 0)      { g = pg8::Gemm{XN, wt + WT_WIN / 2, TP, PN, DM};     E = pg8::EpiAny{0, PROJ, PN, scr};  S.lnN = 4; S.nsu = 32; S.lsplit = 0; S.n17 = 66; }
                else if (k == 4) { g = pg8::Gemm{XN, wt + WT_WOUT / 2, TP, DM, DM};    E = pg8::EpiAny{2, X, DM, scr};     S.lnN = 2; S.nsu = 8;  S.lsplit = 2; }
                else if (k == 6) { g = pg8::Gemm{XN, wt + WT_WUP / 2, TP, DFF, DM};    E = pg8::EpiAny{1, PROJ, DFF, scr}; S.lnN = 4; S.nsu = 32; S.lsplit = 0; }
                else             { g = pg8::Gemm{PROJ, wt + WT_WDOWN / 2, TP, DM, DFF}; E = pg8::EpiAny{2, X, DM, scr};     S.lnN = 2; S.nsu = 8;  S.lsplit = 3; }
                S.ntot = g.K / 64; S.G = (int)gridDim.x; S.c = bidx();
                pg8::gemm_phase(lds, g, S, E);
            }
            else if (k == 1) phase_conv(p, l, xbar);
            else if (k == 2) phase_rec(p, l, lds);
            else if (k == 3) phase_post(p, l);
            else if (k == 5) norm_rows(nullptr, nullptr, X, XN, pin(23) + l * DM, false, scr, 4);
            else { if (l == 0) norm_rows(nullptr, nullptr, X, XN, pin(8) + DM, false, scr, 8);
                   else norm_rows(nullptr, nullptr, X, XN, pin(26), true, scr, 8); }
        }
        if (ph == 3) grid.sync();
        else if (ph < 18) xcd_barrier(xbar);
    }
}

extern "C" void kernel_launch(void* const* d_in, const int* in_sizes, int n_in, void* d_out, int out_size, void* d_ws, size_t ws_size, hipStream_t stream) {
    static int grid = 0;
    if (grid == 0) {
        int dev = 0, cus = 0, per_cu = 0;
        hipGetDevice(&dev);
        hipDeviceGetAttribute(&cus, hipDeviceAttributeMultiprocessorCount, dev);
        hipFuncSetAttribute((const void*)hymba_fwd, hipFuncAttributeMaxDynamicSharedMemorySize, LDS_BYTES);
        hipOccupancyMaxActiveBlocksPerMultiprocessor(&per_cu, (const void*)hymba_fwd, 512, LDS_BYTES);
        if (per_cu < 1) per_cu = 1;
        grid = cus;
        if (grid > 256) grid = 256;
        if (n_in != 27 || (long)out_size != O_END || ws_size < WS_END) fprintf(stderr, "kernel_launch: unexpected sizes n_in %d out %d ws %zu (need %zu)\n", n_in, out_size, ws_size, (size_t)WS_END);
    }
    Params p{};
    for (int i = 0; i < 27; ++i) p.in[i] = (const float*)d_in[i];
    p.out = (float*)d_out; p.ws = (unsigned char*)d_ws;
    (void)hipMemsetAsync((unsigned char*)d_ws + WS_BAR, 0, 16384, stream);
    void* args[] = {&p};
    hipError_t e = hipLaunchCooperativeKernel((const void*)hymba_fwd, dim3(grid), dim3(512), args, LDS_BYTES, stream);
    if (e != hipSuccess) fprintf(stderr, "cooperative launch failed: %s (grid %d)\n", hipGetErrorString(e), grid);
}
```

```cpp
#include <hip/hip_runtime.h>
#include <hip/hip_cooperative_groups.h>
#include <cstdio>
namespace cg = cooperative_groups;

#define LAS __attribute__((address_space(3)))
typedef _Float16 f16_t;
typedef _Float16 f16x8 __attribute__((ext_vector_type(8)));
typedef _Float16 f16x2 __attribute__((ext_vector_type(2)));
typedef float f32x4 __attribute__((ext_vector_type(4)));
typedef unsigned u32x4 __attribute__((ext_vector_type(4)));
typedef unsigned u32x2 __attribute__((ext_vector_type(2)));
typedef float f32x2 __attribute__((ext_vector_type(2)));

constexpr int DM = 1024, NB = 8, SEQ = 2048, NSB = 128, SL = 4, PASTLEN = 16384;
constexpr int TP = NB * SEQ, TS = NSB * SL, TT = TP + TS;
constexpr int PTOT = 4108, PN = 4352, DFF = 4096;
constexpr float EPS = 1e-6f;
constexpr int C_HQ = 0, C_HF = 256, C_HI = 512, C_HG = 768, C_GQKV = 1024, C_GZ = 1792, C_GA = 2048, C_GB = 2052,
              C_RQ = 2056, C_RK = 2312, C_RV = 2568, C_RG = 2824, C_SZ = 3080, C_SXBC = 3336, C_SDT = 4104;
constexpr long O_Y = 0;
constexpr long O_HGRN_P = (long)TT * DM;
constexpr long O_HGRN_S = O_HGRN_P + 2L * NB * 4 * 64 * 64;
constexpr long O_GDN_P = O_HGRN_S + 2L * NSB * 4 * 64 * 64;
constexpr long O_GDN_S = O_GDN_P + 2L * NB * 4 * 64 * 64;
constexpr long O_GDNC_P = O_GDN_S + 2L * NSB * 4 * 64 * 64;
constexpr long O_GDNC_S = O_GDNC_P + 2L * NB * 3 * 768;
constexpr long O_RET_P = O_GDNC_S + 2L * NSB * 3 * 768;
constexpr long O_RET_S = O_RET_P + 2L * NB * 4 * 64 * 64;
constexpr long O_SSD_P = O_RET_S + 2L * NSB * 4 * 64 * 64;
constexpr long O_SSD_S = O_SSD_P + 2L * NB * 4 * 128 * 64;
constexpr long O_SSDC_P = O_SSD_S + 2L * NSB * 4 * 128 * 64;
constexpr long O_SSDC_S = O_SSDC_P + 2L * NB * 3 * 768;
constexpr long O_END = O_SSDC_S + 2L * NSB * 3 * 768;
constexpr size_t WT_WIN = 0, WT_WOUT = WT_WIN + (size_t)PN * DM * 2, WT_WUP = WT_WOUT + (size_t)DM * DM * 2, WT_WDOWN = WT_WUP + (size_t)DFF * DM * 2,
                 WT_LAYER = WT_WDOWN + (size_t)DM * DFF * 2;
constexpr size_t WS_WT = 0, WS_XN = WS_WT + 2 * WT_LAYER, WS_PROJ = WS_XN + (size_t)TT * DM * 2, WS_SCR = WS_PROJ + (size_t)TT * PN * 2,
                 WS_BAR = WS_SCR + (size_t)8 * TS * DM * 4,
                 WS_END = WS_BAR + 16384;
constexpr int LDS_BYTES = 131072 + 64;

struct Params { const float* in[27]; float* out; unsigned char* ws; };

__device__ __forceinline__ void h2f(unsigned w, float& a, float& b) { f16x2 v = __builtin_bit_cast(f16x2, w); a = (float)v.x; b = (float)v.y; }
__device__ __forceinline__ unsigned pkh(float a, float b) { f16x2 v; v.x = (f16_t)a; v.y = (f16_t)b; return __builtin_bit_cast(unsigned, v); }
__device__ __forceinline__ float hload(const f16_t* p) { return (float)(*p); }
__device__ __forceinline__ float sigmoidf_(float x) { return 1.0f / (1.0f + __expf(-x)); }
__device__ __forceinline__ float siluf_(float x) { return x / (1.0f + __expf(-x)); }
__device__ __forceinline__ float softplusf_(float x) { return x > 20.f ? x : log1pf(expf(x)); }
template <int CTRL> __device__ __forceinline__ float dppf(float x) { return __builtin_bit_cast(float, __builtin_amdgcn_update_dpp(0, __builtin_bit_cast(int, x), CTRL, 0xF, 0xF, true)); }
__device__ __forceinline__ float red4(float x) { x += dppf<0xB1>(x); x += dppf<0x4E>(x); return x; }
__device__ __forceinline__ float red8(float x) { x = red4(x); x += dppf<0x141>(x); return x; }
__device__ __forceinline__ float red16(float x) { x = red8(x); x += dppf<0x140>(x); return x; }
__device__ __forceinline__ void u4f(const u32x4& u, float (&f)[8]) { h2f(u.x, f[0], f[1]); h2f(u.y, f[2], f[3]); h2f(u.z, f[4], f[5]); h2f(u.w, f[6], f[7]); }
__device__ __forceinline__ void u2f(const u32x2& u, float (&f)[4]) { h2f(u.x, f[0], f[1]); h2f(u.y, f[2], f[3]); }
__device__ __forceinline__ float red64(float x) { x = red16(x); x += __shfl_xor(x, 16); x += __shfl_xor(x, 32); return x; }

__device__ __forceinline__ int tidx() { int t = threadIdx.x; asm volatile("" : "+v"(t)); return t; }
__device__ __forceinline__ int bidx() { int t = blockIdx.x; asm volatile("" : "+s"(t)); return t; }

typedef const __attribute__((address_space(4))) Params* KArgP;
__device__ __forceinline__ KArgP kargs() { KArgP pp = (KArgP)__builtin_amdgcn_kernarg_segment_ptr(); asm volatile("" : "+s"(pp)); return pp; }
__device__ __forceinline__ const float* pin(int i) { return kargs()->in[i]; }
__device__ __forceinline__ float* pout() { return kargs()->out; }
__device__ __forceinline__ unsigned char* pws() { return kargs()->ws; }

#define XB_TMO      128
#define XB_XCNT(j)  (256  + 64 * (j))
#define XB_XSUB(j)  (1280 + 64 * (j))
#define XB_XGEN(j)  (2304 + 64 * (j))
#define XB_TOP      3328
#define XB_TOPGEN   3392
#define XCD_BAR_WORDS 3456
#define XB_SPIN_CAP (1u << 18)
__device__ __forceinline__ unsigned xb_ld(unsigned* p)              { return __hip_atomic_load(p, __ATOMIC_RELAXED, __HIP_MEMORY_SCOPE_AGENT); }
__device__ __forceinline__ unsigned xb_add(unsigned* p, unsigned v) { return __hip_atomic_fetch_add(p, v, __ATOMIC_RELAXED, __HIP_MEMORY_SCOPE_AGENT); }
__device__ __forceinline__ unsigned xb_xcc_id() { return (unsigned)__builtin_amdgcn_s_getreg((3 << 11) | 20) & 0xFu; }
#define XB_SPIN(cond, bar) do { unsigned _sp = 0; while (cond) { __builtin_amdgcn_s_sleep(1); \
    if ((++_sp & 255u) == 0u) { if (xb_ld(&(bar)[XB_TMO])) break; if (_sp > XB_SPIN_CAP) { atomicAdd(&(bar)[XB_TMO], 1u); break; } } } } while (0)
struct XcdBarrier { unsigned* bar; unsigned x; volatile LAS unsigned* st; };
__device__ __forceinline__ XcdBarrier xcd_barrier_post(unsigned* bar, volatile LAS unsigned* st) {
    XcdBarrier b; b.bar = bar; b.x = xb_xcc_id(); b.st = st;
    if (threadIdx.x == 0) (void)xb_add(&bar[XB_XCNT(b.x)], 1u);
    return b;
}
__device__ __forceinline__ void xcd_barrier_complete(unsigned* bar, unsigned x, unsigned& nloc, unsigned& nx) {
    const unsigned G = gridDim.x * gridDim.y * gridDim.z;
    unsigned sum, cnt, mine, sp = 0u;
    for (;;) {
        sum = 0u; cnt = 0u; mine = 0u;
#pragma unroll
        for (unsigned j = 0; j < 16; ++j) { const unsigned c = xb_ld(&bar[XB_XCNT(j)]); sum += c; cnt += (c > 0u) ? 1u : 0u; mine = (j == x) ? c : mine; }
        if (sum == G) break;
        __builtin_amdgcn_s_sleep(1);
        if ((++sp & 255u) == 0u) { if (xb_ld(&bar[XB_TMO])) break; if (sp > XB_SPIN_CAP) { atomicAdd(&bar[XB_TMO], 1u); break; } }
    }
    nloc = mine > 0u ? mine : 1u; nx = cnt > 0u ? cnt : 1u;
}
__device__ __forceinline__ void xcd_barrier(const XcdBarrier& b) {
    asm volatile("s_waitcnt vmcnt(0)" ::: "memory");
    __syncthreads();
    if (threadIdx.x == 0) {
        unsigned* bar = b.bar;
        __builtin_amdgcn_s_waitcnt(0);
        unsigned nloc = b.st[0], nx = b.st[1];
        if (nloc == 0u) { xcd_barrier_complete(bar, b.x, nloc, nx); b.st[0] = nloc; b.st[1] = nx; }
        const unsigned old = xb_add(&bar[XB_XSUB(b.x)], 1u);
        const unsigned gen = old / nloc;
        if (old + 1u == (gen + 1u) * nloc) {
            __builtin_amdgcn_fence(__ATOMIC_RELEASE, "agent");
            asm volatile("s_waitcnt vmcnt(0)" ::: "memory");
            const unsigned og = xb_add(&bar[XB_TOP], 1u);
            const unsigned tg = og / nx;
            if (og + 1u == (tg + 1u) * nx) xb_add(&bar[XB_TOPGEN], 1u);
            else XB_SPIN(xb_ld(&bar[XB_TOPGEN]) == tg, bar);
            __builtin_amdgcn_fence(__ATOMIC_ACQUIRE, "agent");
            xb_add(&bar[XB_XGEN(b.x)], 1u);
            asm volatile("s_waitcnt vmcnt(0)" ::: "memory");
        } else {
            XB_SPIN(xb_ld(&bar[XB_XGEN(b.x)]) == gen, bar);
            __builtin_amdgcn_fence(__ATOMIC_ACQUIRE, "agent");
            asm volatile("s_waitcnt vmcnt(0)" ::: "memory");
        }
    }
    __syncthreads();
}

namespace pg8 {
constexpr int BM = 256, BK = 64, HALF = 128, HTB = HALF * BK * 2, STAGE_BYTES = 8 * HTB, NXCD = 8, WGM = 8;
__host__ __device__ __forceinline__ int lds_byte(int r, int c) { const int st = (r >> 4) * 2 + (c >> 5), rr = r & 15, cc = c & 31, ob = rr * 64 + cc * 2; return st * 1024 + (ob ^ (((ob >> 9) & 1) << 5)); }
__host__ __device__ __forceinline__ void stage_rc(int b, int& R, int& C) { const int st = b / 1024, sb = b % 1024, swz = sb ^ (((sb >> 9) & 1) << 5); R = (st >> 1) * 16 + swz / 64; C = (st & 1) * 32 + (swz % 64) / 2; }
__host__ __device__ __forceinline__ int perm32(int rho) { const int n = rho >> 4, i = rho & 15; return 8 * (i >> 2) + 4 * n + (i & 3); }
struct Unit { int pm, pn, k0, nt, sl; };
struct Gemm { const f16_t* A; const f16_t* Bt; int M, N, K; };
struct PowOrder {
    int G, c, lnN, ntot, nsu, lsplit, n17;
    __device__ __forceinline__ bool next(int i, Unit& u) const {
        const int L = i * G + c, nwg = 64 << lnN, e = L - nwg, ns = nsu << lsplit, f = e - ns;
        const bool mainp = L < nwg, samp = !mainp && e < ns;
        const int wgid = (L & 7) * (nwg >> 3) + (L >> 3), within = wgid & ((8 << lnN) - 1);
        const int su = e >> lsplit, sl = e & ((1 << lsplit) - 1), nts = ntot >> lsplit;
        const int pm = mainp ? (wgid >> (3 + lnN)) * 8 + (within & 7) : (samp ? 64 + (su >> lnN) : f);
        const int pn = mainp ? within >> 3 : (samp ? su & ((1 << lnN) - 1) : (1 << lnN));
        const int k0 = (samp && lsplit) ? -1 - sl * nts : 0;
        const int nt = samp ? nts : ntot;
        u.pm = pm; u.pn = pn; u.k0 = k0; u.nt = nt; u.sl = sl;
        return mainp || samp || f < n17;
    }
    __device__ __forceinline__ void a_ready(const Unit&) const {}
    __device__ __forceinline__ void done(const Unit&) const {}
};
struct EpiAny {
    int mode; void* out; int ldc; float* scr;
    __device__ __forceinline__ bool perm() const { return mode != 2; }
    __device__ __forceinline__ void operator()(const f32x4 (&acc)[2][2][4][2], const Unit& u, int wr, int wc, int fr, int fq) const {
        if (mode == 2) {
            float* C = (float*)out;
            const int row0 = u.pm * BM + wr * 64 + fr, col0 = u.pn * BM + wc * 32 + 4 * fq;
#pragma unroll
            for (int ai = 0; ai < 2; ++ai)
#pragma unroll
                for (int m = 0; m < 4; ++m) { float* rowp = C + (size_t)(row0 + ai * HALF + m * 16) * ldc + col0;
#pragma unroll
                    for (int bj = 0; bj < 2; ++bj)
#pragma unroll
                        for (int n = 0; n < 2; ++n) { float* q = rowp + bj * HALF + n * 16; const f32x4 v = acc[ai][bj][m][n];
                            if (u.k0 < 0) *(f32x4*)(scr + (size_t)u.sl * TS * DM + (q - C) - (size_t)64 * BM * ldc) = v;
                            else *(f32x4*)q = *(f32x4*)q + v; } }
        } else {
            f16_t* O = (f16_t*)out;
            const int row0 = u.pm * BM + wr * 64 + fr; const int col0 = u.pn * BM + wc * 32 + 8 * fq;
            const float lo = mode == 1 ? 0.f : -3.0e38f;
#pragma unroll
            for (int ai = 0; ai < 2; ++ai)
#pragma unroll
                for (int m = 0; m < 4; ++m) { f16_t* rowp = O + (size_t)(row0 + ai * HALF + m * 16) * ldc + col0;
#pragma unroll
                    for (int bj = 0; bj < 2; ++bj) { f32x4 v0 = acc[ai][bj][m][0], v1 = acc[ai][bj][m][1];
                        if (mode == 1) {
#pragma unroll
                            for (int j = 0; j < 4; ++j) { float a = fmaxf(v0[j], lo), b = fmaxf(v1[j], lo); v0[j] = a * a; v1[j] = b * b; } }
                        u32x4 w; w.x = pkh(v0[0], v0[1]); w.y = pkh(v0[2], v0[3]); w.z = pkh(v1[0], v1[1]); w.w = pkh(v1[2], v1[3]);
                        *(u32x4*)(rowp + bj * HALF) = w; } }
        }
    }
};

template <class Epi, class Sched>
__device__ __forceinline__ void gemm_phase(LAS unsigned char* lds, const Gemm g, const Sched& S, const Epi& E) {
    const int tid = tidx(), wid = __builtin_amdgcn_readfirstlane(tid >> 6), lane = tid & 63, wr = wid >> 2, wc = wid & 3, fr = lane & 15, fq = lane >> 4;
    const int K = g.K;
    unsigned voffA[2], voffB[2];
#pragma unroll
    for (int i = 0; i < 2; ++i) { int R, C; stage_rc(tid * 16 + i * 8192, R, C); const int Rb = E.perm() ? ((R & ~31) + perm32(R & 31)) : R;
        voffA[i] = (unsigned)(R * K + C) * 2u; voffB[i] = (unsigned)(Rb * K + C) * 2u; }
    const size_t kstep = (size_t)(BK * 2);
    const size_t hstep = (size_t)HALF * K * 2;
    const size_t tstep = 2 * hstep;
    const unsigned ldsw = (unsigned)wid * 1024u;
    const int aoff = lds_byte(wr * 64 + fr, fq * 8), boff = lds_byte(wc * 32 + fr, fq * 8);
#define PG8_SA(b, h) (((b) * 2 + (h)) * HTB)
#define PG8_SB(b, h) ((4 + (b) * 2 + (h)) * HTB)
#define PG8_STAGE(bufoff, gbase, voff) do { _Pragma("unroll") for (int _i = 0; _i < 2; ++_i) \
        __builtin_amdgcn_global_load_lds((const unsigned*)((const char*)(gbase) + (voff)[_i]), (LAS unsigned*)(lds + (bufoff) + ldsw + _i * 8192), 16, 0, 0); } while (0)
#define PG8_LDA(dst, b, h) do { _Pragma("unroll") for (int m = 0; m < 4; ++m) _Pragma("unroll") for (int k = 0; k < 2; ++k) dst[m][k] = *(const LAS f16x8*)(lds + PG8_SA(b, h) + aoff + m * 2048 + k * 1024); } while (0)
#define PG8_LDB(dst, b, h) do { _Pragma("unroll") for (int n = 0; n < 2; ++n) _Pragma("unroll") for (int k = 0; k < 2; ++k) dst[n][k] = *(const LAS f16x8*)(lds + PG8_SB(b, h) + boff + n * 2048 + k * 1024); } while (0)
#define PG8_MMA(ai, bj, At, Bt) do { __builtin_amdgcn_s_setprio(1); _Pragma("unroll") for (int m = 0; m < 4; ++m) _Pragma("unroll") for (int n = 0; n < 2; ++n) _Pragma("unroll") for (int k = 0; k < 2; ++k) \
        acc[ai][bj][m][n] = __builtin_amdgcn_mfma_f32_16x16x32_f16(Bt[n][k], At[m][k], acc[ai][bj][m][n], 0, 0, 0); __builtin_amdgcn_s_setprio(0); } while (0)
#define PG8_WAIT_V(n) asm volatile("s_waitcnt vmcnt(" #n ")" ::: "memory")
#define PG8_WAIT_L(n) asm volatile("s_waitcnt lgkmcnt(" #n ")" ::: "memory")
#define PG8_BAR __builtin_amdgcn_s_barrier()
#define PG8_SCHED __builtin_amdgcn_sched_barrier(0)
    Unit cur, nxt; int ui = 0;
    if (!S.next(0, cur)) return;
    f32x4 acc[2][2][4][2];
#pragma unroll
    for (int a = 0; a < 2; ++a)
#pragma unroll
        for (int b = 0; b < 2; ++b)
#pragma unroll
            for (int m = 0; m < 4; ++m)
#pragma unroll
                for (int n = 0; n < 2; ++n) acc[a][b][m][n] = (f32x4){0.f, 0.f, 0.f, 0.f};
    f16x8 At[4][2], B0[2][2], B1[2][2];
    const char* cA = (const char*)g.A + (size_t)cur.pm * tstep + (size_t)(cur.k0 < 0 ? -1 - cur.k0 : cur.k0) * kstep; const char* cB = (const char*)g.Bt + (size_t)cur.pn * tstep + (size_t)(cur.k0 < 0 ? -1 - cur.k0 : cur.k0) * kstep;
    S.a_ready(cur);
    PG8_STAGE(PG8_SB(0, 0), cB, voffB); PG8_STAGE(PG8_SA(0, 0), cA, voffA); PG8_STAGE(PG8_SB(0, 1), cB + hstep, voffB); PG8_STAGE(PG8_SA(0, 1), cA + hstep, voffA);
    if (wr == 1) PG8_BAR;
    PG8_WAIT_V(4); PG8_BAR;
    PG8_STAGE(PG8_SB(1, 0), cB + kstep, voffB); PG8_STAGE(PG8_SA(1, 0), cA + kstep, voffA); PG8_STAGE(PG8_SB(1, 1), cB + hstep + kstep, voffB);
    PG8_WAIT_V(6); PG8_BAR;
    for (;;) {
        const bool has_next = S.next(ui + 1, nxt);
        const char* nA = has_next ? (const char*)g.A + (size_t)nxt.pm * tstep + (size_t)(nxt.k0 < 0 ? -1 - nxt.k0 : nxt.k0) * kstep : cA; const char* nB = has_next ? (const char*)g.Bt + (size_t)nxt.pn * tstep + (size_t)(nxt.k0 < 0 ? -1 - nxt.k0 : nxt.k0) * kstep : cB;
        const int nt = cur.nt;
        for (int t = 0; t < nt; t += 2) {
            const bool last = (t == nt - 2);
            const char* a1 = cA + (size_t)(t + 1) * kstep;
            const char* a2 = last ? nA : cA + (size_t)(t + 2) * kstep; const char* b2 = last ? nB : cB + (size_t)(t + 2) * kstep;
            const char* a3 = a2 + kstep; const char* b3 = b2 + kstep;
            if (last && has_next) S.a_ready(nxt);
            PG8_LDB(B0, 0, 0); PG8_SCHED; PG8_LDA(At, 0, 0); PG8_STAGE(PG8_SA(1, 1), a1 + hstep, voffA);
            PG8_WAIT_L(8); PG8_BAR; PG8_WAIT_L(0); PG8_MMA(0, 0, At, B0); PG8_BAR; PG8_SCHED;
            PG8_LDB(B1, 0, 1); PG8_STAGE(PG8_SB(0, 0), b2, voffB);
            PG8_BAR; PG8_WAIT_L(0); PG8_MMA(0, 1, At, B1); PG8_BAR;
            PG8_LDA(At, 0, 1); PG8_STAGE(PG8_SA(0, 0), a2, voffA);
            PG8_BAR; PG8_WAIT_L(0); PG8_MMA(1, 0, At, B0); PG8_BAR; PG8_SCHED;
            PG8_STAGE(PG8_SB(0, 1), b2 + hstep, voffB);
            PG8_WAIT_V(6); PG8_BAR; PG8_MMA(1, 1, At, B1); PG8_BAR;
            PG8_LDB(B0, 1, 0); PG8_SCHED; PG8_LDA(At, 1, 0); PG8_STAGE(PG8_SA(0, 1), a2 + hstep, voffA);
            PG8_WAIT_L(8); PG8_BAR; PG8_WAIT_L(0); PG8_MMA(0, 0, At, B0); PG8_BAR; PG8_SCHED;
            PG8_LDB(B1, 1, 1); PG8_STAGE(PG8_SB(1, 0), b3, voffB);
            PG8_BAR; PG8_WAIT_L(0); PG8_MMA(0, 1, At, B1); PG8_BAR;
            PG8_LDA(At, 1, 1); PG8_STAGE(PG8_SA(1, 0), a3, voffA);
            PG8_BAR; PG8_WAIT_L(0); PG8_MMA(1, 0, At, B0); PG8_BAR; PG8_SCHED;
            PG8_STAGE(PG8_SB(1, 1), b3 + hstep, voffB);
            PG8_WAIT_V(6); PG8_BAR; PG8_MMA(1, 1, At, B1); PG8_BAR;
        }
        E(acc, cur, wr, wc, fr, fq); S.done(cur);
        if (!has_next) break;
#pragma unroll
        for (int a = 0; a < 2; ++a)
#pragma unroll
            for (int b = 0; b < 2; ++b)
#pragma unroll
                for (int m = 0; m < 4; ++m)
#pragma unroll
                    for (int n = 0; n < 2; ++n) acc[a][b][m][n] = (f32x4){0.f, 0.f, 0.f, 0.f};
        cur = nxt; cA = nA; cB = nB; ++ui;
    }
    PG8_WAIT_V(0);
    if (wr == 0) PG8_BAR;
    PG8_BAR;
#undef PG8_SA
#undef PG8_SB
#undef PG8_STAGE
#undef PG8_LDA
#undef PG8_LDB
#undef PG8_MMA
#undef PG8_WAIT_V
#undef PG8_WAIT_L
#undef PG8_BAR
#undef PG8_SCHED
}
}

__device__ __forceinline__ void narrow_cols(const f16_t* XN, const f16_t* WinT, f16_t* PROJ) {
    const int tid = tidx(), lane = tid & 63, fr = lane & 15, fq = lane >> 4, gw = bidx() * 8 + (tid >> 6), nw = gridDim.x * 8;
    for (int t = gw; t < TT / 16; t += nw) {
        const f16_t* ap = XN + (size_t)(t * 16 + fr) * DM + fq * 8;
        const f16_t* bp = WinT + (size_t)(4096 + fr) * DM + fq * 8;
        f32x4 acc = (f32x4){0.f, 0.f, 0.f, 0.f};
#pragma unroll 8
        for (int kk = 0; kk < DM; kk += 32) acc = __builtin_amdgcn_mfma_f32_16x16x32_f16(*(const f16x8*)(ap + kk), *(const f16x8*)(bp + kk), acc, 0, 0, 0);
#pragma unroll
        for (int r = 0; r < 4; ++r) PROJ[(size_t)(t * 16 + fq * 4 + r) * PN + 4096 + fr] = (f16_t)acc[r];
    }
}
__device__ __forceinline__ void scr_zero() {
    f32x4* s = (f32x4*)(pws() + WS_SCR);
    for (int i = bidx() * 512 + tidx(); i < TS * 4096 / 4; i += gridDim.x * 512) s[i] = (f32x4){0.f, 0.f, 0.f, 0.f};
}
__device__ __forceinline__ void scr_convert(f16_t* O, int ldc, bool relu2) {
    const f32x4* s = (const f32x4*)(pws() + WS_SCR);
    for (int i = bidx() * 512 + tidx(); i < TS * 4096 / 4; i += gridDim.x * 512) {
        f32x4 v = s[i]; const int r = i >> 10, c = (i & 1023) * 4;
        if (relu2) {
#pragma unroll
            for (int j = 0; j < 4; ++j) { const float a = fmaxf(v[j], 0.f); v[j] = a * a; } }
        u32x2 w; w.x = pkh(v[0], v[1]); w.y = pkh(v[2], v[3]);
        *(u32x2*)(O + (size_t)(TP + r) * ldc + c) = w;
    }
}

__device__ __forceinline__ void norm_rows(const float* srcP, const float* srcS, float* X, f16_t* XN, const float* g, bool final_inplace, const float* scr = nullptr, int nsl = 0, bool copy_x = true) {
    const int lane = tidx() & 63, gw = bidx() * 8 + (tidx() >> 6), nw = gridDim.x * 8;
    f32x4 gv[4];
#pragma unroll
    for (int i = 0; i < 4; ++i) gv[i] = *(const f32x4*)(g + i * 256 + lane * 4);
    for (int r0 = gw; r0 < TT; r0 += 4 * nw) {
        f32x4 v[4][4];
#pragma unroll
        for (int b = 0; b < 4; ++b) { const int r = r0 + b * nw;
            if (r < TT) { const float* src = srcP ? (r < TP ? srcP + (size_t)r * DM : srcS + (size_t)(r - TP) * DM) : X + (size_t)r * DM;
#pragma unroll
                for (int i = 0; i < 4; ++i) v[b][i] = *(const f32x4*)(src + i * 256 + lane * 4); } }
#pragma unroll
        for (int b = 0; b < 4; ++b) { const int r = r0 + b * nw;
            if (r < TT) {
                float ss = 0.f;
#pragma unroll
                for (int i = 0; i < 4; ++i) {
                    if (nsl && r >= TP) {
                        const float* s = scr + (size_t)(r - TP) * DM + i * 256 + lane * 4;
                        for (int q = 0; q < nsl; ++q) v[b][i] = v[b][i] + *(const f32x4*)(s + (size_t)q * TS * DM);
                        if (!final_inplace) *(f32x4*)(X + (size_t)r * DM + i * 256 + lane * 4) = v[b][i]; }
                    ss += v[b][i][0] * v[b][i][0] + v[b][i][1] * v[b][i][1] + v[b][i][2] * v[b][i][2] + v[b][i][3] * v[b][i][3]; }
                ss = red64(ss);
                const float sc = rsqrtf(ss * (1.0f / DM) + EPS);
#pragma unroll
                for (int i = 0; i < 4; ++i) {
                    if (srcP && copy_x) *(f32x4*)(X + (size_t)r * DM + i * 256 + lane * 4) = v[b][i];
                    f32x4 o = v[b][i] * sc * gv[i];
                    if (final_inplace) *(f32x4*)(X + (size_t)r * DM + i * 256 + lane * 4) = o;
                    else { u32x2 w; w.x = pkh(o[0], o[1]); w.y = pkh(o[2], o[3]); *(u32x2*)(XN + (size_t)r * DM + i * 256 + lane * 4) = w; }
                } } }
    }
}

struct TileJob { const float* W; f16_t* Bt; int Kdim, Nreal, tk, tn; };
__device__ __forceinline__ TileJob tile_job(int t) {
    constexpr int n_in = 16 * (PN / 64), n_out = 16 * 16, n_up = 16 * 64, n_dn = 64 * 16, tot = n_in + n_out + n_up + n_dn;
    const int l = t >= tot ? 1 : 0, u0 = t - l * tot;
    f16_t* wt = (f16_t*)(pws() + WS_WT + l * WT_LAYER);
    TileJob j;
    if (u0 < n_in) { j = TileJob{pin(9) + (size_t)l * DM * PTOT, wt + WT_WIN / 2, DM, PTOT, u0 % 16, u0 / 16}; }
    else if (u0 < n_in + n_out) { const int u = u0 - n_in; j = TileJob{pin(22) + (size_t)l * DM * DM, wt + WT_WOUT / 2, DM, DM, u % 16, u / 16}; }
    else if (u0 < n_in + n_out + n_up) { const int u = u0 - n_in - n_out; j = TileJob{pin(24) + (size_t)l * DM * DFF, wt + WT_WUP / 2, DM, DFF, u % 16, u / 16}; }
    else { const int u = u0 - n_in - n_out - n_up; j = TileJob{pin(25) + (size_t)l * DFF * DM, wt + WT_WDOWN / 2, DFF, DM, u % 64, u / 64}; }
    return j;
}
__device__ __forceinline__ void tile_load(const TileJob& j, f32x4 (&v)[2]) {
    const int tid = tidx(), k0 = j.tk * 64, n0 = j.tn * 64;
#pragma unroll
    for (int i = 0; i < 2; ++i) { const int r = (tid >> 4) + 32 * i, c = (tid & 15) * 4, n = n0 + c;
        v[i] = (f32x4){0.f, 0.f, 0.f, 0.f};
        if (n < j.Nreal) v[i] = *(const f32x4*)(j.W + (size_t)(k0 + r) * j.Nreal + n); }
}
__device__ __forceinline__ void tile_store(const TileJob& j, const f32x4 (&v)[2], LAS float* tile) {
    const int tid = tidx(), k0 = j.tk * 64, n0 = j.tn * 64;
#pragma unroll
    for (int i = 0; i < 2; ++i) { const int r = (tid >> 4) + 32 * i, c = (tid & 15) * 4;
        tile[r * 65 + c] = v[i][0]; tile[r * 65 + c + 1] = v[i][1]; tile[r * 65 + c + 2] = v[i][2]; tile[r * 65 + c + 3] = v[i][3]; }
    __syncthreads();
    { const int nl = tid >> 3, k8 = (tid & 7) * 8; u32x4 w;
      w.x = pkh(tile[(k8 + 0) * 65 + nl], tile[(k8 + 1) * 65 + nl]); w.y = pkh(tile[(k8 + 2) * 65 + nl], tile[(k8 + 3) * 65 + nl]);
      w.z = pkh(tile[(k8 + 4) * 65 + nl], tile[(k8 + 5) * 65 + nl]); w.w = pkh(tile[(k8 + 6) * 65 + nl], tile[(k8 + 7) * 65 + nl]);
      *(u32x4*)(j.Bt + (size_t)(n0 + nl) * j.Kdim + k0 + k8) = w; }
    __syncthreads();
}
__device__ __forceinline__ void convert_tiles(int t0, int t1, int step, LAS float* tile) {
    int t = t0;
    if (t < t1) {
        TileJob cur = tile_job(t); f32x4 v[2]; tile_load(cur, v);
        for (;;) {
            const int tn = t + step; const bool more = tn < t1;
            TileJob nxt = cur; f32x4 vn[2];
            if (more) { nxt = tile_job(tn); tile_load(nxt, vn); }
            tile_store(cur, v, tile);
            if (!more) break;
            cur = nxt; v[0] = vn[0]; v[1] = vn[1]; t = tn;
        }
    }
}
constexpr int N_TILES_WIN0 = 16 * (PN / 64);
constexpr int N_TILES_ALL = 2 * (16 * (PN / 64) + 16 * 16 + 16 * 64 + 64 * 16);
__device__ __forceinline__ void phase_prologue(const Params& p, LAS unsigned char* lds) {
    convert_tiles(bidx(), N_TILES_WIN0, gridDim.x, (LAS float*)lds);
    norm_rows(pin(0), pin(1), pout() + O_Y, (f16_t*)(pws() + WS_XN), pin(8), false, nullptr, 0, false);
}
__device__ __forceinline__ void copy_x_rows(int r0, int n) {
    const f32x4* xp = (const f32x4*)pin(0); const f32x4* xs = (const f32x4*)pin(1); f32x4* X = (f32x4*)(pout() + O_Y);
    for (int i = tidx(); i < n * 256; i += 512) { const size_t e = (size_t)r0 * 256 + i;
        X[e] = e < (size_t)TP * 256 ? xp[e] : xs[e - (size_t)TP * 256]; }
}

__device__ __forceinline__ void phase_conv(const Params& p, int l, const XcdBarrier& xbar) {
    f16_t* proj = (f16_t*)(pws() + WS_PROJ);
    const int g = bidx() * 512 + tidx();
    constexpr int NPI = (TP / 32) * 192, NSI = NSB * 192;
    const int kind = g < NPI ? 0 : (g - NPI < NSI ? 1 : 2);
    const int gi = kind == 0 ? g : (kind == 1 ? g - NPI : 0);
    const int cgi = gi % 192, unit = gi / 192;
    const bool ssd = cgi >= 96; const int ch = (ssd ? cgi - 96 : cgi) * 8;
    const int col = (ssd ? C_SXBC : C_GQKV) + ch;
    const float* cw = (ssd ? pin(16) : pin(12)) + (size_t)l * 4 * 768 + ch;
    float w[4][8], bias[8];
#pragma unroll
    for (int j = 0; j < 4; ++j) { const f32x4 a = *(const f32x4*)(cw + j * 768), b = *(const f32x4*)(cw + j * 768 + 4);
#pragma unroll
        for (int e = 0; e < 4; ++e) { w[j][e] = a[e]; w[j][e + 4] = b[e]; } }
#pragma unroll
    for (int e = 0; e < 8; ++e) bias[e] = ssd ? pin(17)[l * 768 + ch + e] : 0.f;
    u32x4 h[3];
#pragma unroll
    for (int i = 0; i < 3; ++i) h[i] = (u32x4){0, 0, 0, 0};
    const int row0 = kind == 0 ? unit * 32 : TP + unit * 4;
    if (kind == 0) { if ((row0 % SEQ) != 0) {
#pragma unroll
            for (int i = 0; i < 3; ++i) h[i] = *(const u32x4*)(proj + (size_t)(row0 - 3 + i) * PN + col); } }
    else if (kind == 1) { const float* st = (ssd ? pin(7) : pin(4)) + (size_t)((l * NSB + unit) * 3) * 768 + ch;
#pragma unroll
        for (int i = 0; i < 3; ++i) { const f32x4 a = *(const f32x4*)(st + i * 768), b = *(const f32x4*)(st + i * 768 + 4);
            h[i] = (u32x4){pkh(a[0], a[1]), pkh(a[2], a[3]), pkh(b[0], b[1]), pkh(b[2], b[3])}; } }
    xcd_barrier(xbar);
    if (kind == 0) {
#pragma unroll 1
        for (int hb = 1; hb >= 0; --hb) {
            const int r = row0 + 16 * hb;
            u32x4 cur[16], pre[3];
#pragma unroll
            for (int i = 0; i < 16; ++i) cur[i] = *(const u32x4*)(proj + (size_t)(r + i) * PN + col);
#pragma unroll
            for (int i = 0; i < 3; ++i) { pre[i] = h[i]; if (hb) pre[i] = *(const u32x4*)(proj + (size_t)(r - 3 + i) * PN + col); }
            if (hb && ((row0 + 32) % SEQ) == 0) {
                float* so = pout() + (ssd ? O_SSDC_P : O_GDNC_P) + (size_t)((l * NB + row0 / SEQ) * 3) * 768 + ch;
#pragma unroll
                for (int i = 0; i < 3; ++i) { float t[8]; u4f(cur[13 + i], t);
                    *(f32x4*)(so + i * 768) = (f32x4){t[0], t[1], t[2], t[3]}; *(f32x4*)(so + i * 768 + 4) = (f32x4){t[4], t[5], t[6], t[7]}; }
            }
            float w0[8], w1[8], w2[8];
            u4f(pre[0], w0); u4f(pre[1], w1); u4f(pre[2], w2);
#pragma unroll
            for (int i = 0; i < 16; ++i) { float w3[8], o[8]; u4f(cur[i], w3);
#pragma unroll
                for (int e = 0; e < 8; ++e) { const float a = bias[e] + w[0][e] * w0[e] + w[1][e] * w1[e] + w[2][e] * w2[e] + w[3][e] * w3[e]; o[e] = siluf_(a); w0[e] = w1[e]; w1[e] = w2[e]; w2[e] = w3[e]; }
                *(u32x4*)(proj + (size_t)(r + i) * PN + col) = (u32x4){pkh(o[0], o[1]), pkh(o[2], o[3]), pkh(o[4], o[5]), pkh(o[6], o[7])}; }
        }
    } else if (kind == 1) {
        u32x4 cur[4];
#pragma unroll
        for (int i = 0; i < 4; ++i) cur[i] = *(const u32x4*)(proj + (size_t)(row0 + i) * PN + col);
        float win[7][8];
#pragma unroll
        for (int i = 0; i < 3; ++i) u4f(h[i], win[i]);
#pragma unroll
        for (int i = 0; i < 4; ++i) u4f(cur[i], win[3 + i]);
        float* so = pout() + (ssd ? O_SSDC_S : O_GDNC_S) + (size_t)((l * NSB + unit) * 3) * 768 + ch;
#pragma unroll
        for (int i = 0; i < 3; ++i) { *(f32x4*)(so + i * 768) = (f32x4){win[4 + i][0], win[4 + i][1], win[4 + i][2], win[4 + i][3]};
            *(f32x4*)(so + i * 768 + 4) = (f32x4){win[4 + i][4], win[4 + i][5], win[4 + i][6], win[4 + i][7]}; }
#pragma unroll
        for (int i = 0; i < 4; ++i) { float o[8];
#pragma unroll
            for (int e = 0; e < 8; ++e) { float a = bias[e];
#pragma unroll
                for (int j = 0; j < 4; ++j) a += w[j][e] * win[i + j][e];
                o[e] = siluf_(a); }
            *(u32x4*)(proj + (size_t)(row0 + i) * PN + col) = (u32x4){pkh(o[0], o[1]), pkh(o[2], o[3]), pkh(o[4], o[5]), pkh(o[6], o[7])}; }
    }
}

template <int MIX> struct RecCfg { static constexpr int K = (MIX == 3 ? 128 : 64), KPL = K / 16, KS = (MIX == 3 ? 132 : 64);
    static constexpr int OFF_Q = 0, OFF_K = 64 * KS, OFF_F = 2 * 64 * KS, OFF_V = (MIX == 0 ? 3 : 2) * 64 * KS, OFF_XSD = OFF_V + 2048, OFF_SC = OFF_XSD + 2048, OFF_O = OFF_SC + 256; };

template <int MIX> struct Raw;
template <> struct Raw<0> { u32x4 hq, hf; u32x2 hi; };
template <> struct Raw<1> { u32x4 q, k; u32x2 v; float ga, gb; };
template <> struct Raw<2> { u32x2 q1, q2, k1, k2, v; };
template <> struct Raw<3> { u32x4 b[2], c[2]; u32x2 x; float dt; };

struct Slot { int row, pos, seq; };

template <bool SAMPLE> __device__ __forceinline__ Slot slot_of(int chunk, int s, int sg) {
    Slot r;
    if (SAMPLE) { r.seq = sg * 16 + (s >> 2); r.pos = s & 3; r.row = TP + r.seq * 4 + r.pos; }
    else { r.seq = 0; r.pos = chunk * 64 + s; r.row = sg * SEQ + r.pos; }
    return r;
}

template <int MIX, bool SAMPLE>
__device__ __forceinline__ void rec_load(Raw<MIX>& R, const f16_t* proj, int chunk, int sg, int head, int vcol0) {
    const int tid = tidx(), s = tid >> 3, cgi = tid & 7;
    const Slot sl = slot_of<SAMPLE>(chunk, s, sg);
    const f16_t* rowp = proj + (size_t)sl.row * PN;
    if constexpr (MIX == 0) {
        R.hq = *(const u32x4*)(rowp + C_HQ + head * 64 + cgi * 8);
        R.hf = *(const u32x4*)(rowp + C_HF + head * 64 + cgi * 8);
        R.hi = *(const u32x2*)(rowp + C_HI + head * 64 + vcol0 + cgi * 4);
    } else if constexpr (MIX == 1) {
        R.q = *(const u32x4*)(rowp + C_GQKV + head * 64 + cgi * 8);
        R.k = *(const u32x4*)(rowp + C_GQKV + 256 + head * 64 + cgi * 8);
        R.v = *(const u32x2*)(rowp + C_GQKV + 512 + head * 64 + vcol0 + cgi * 4);
        R.ga = hload(rowp + C_GA + head); R.gb = hload(rowp + C_GB + head);
    } else if constexpr (MIX == 2) {
        R.q1 = *(const u32x2*)(rowp + C_RQ + head * 64 + cgi * 4); R.q2 = *(const u32x2*)(rowp + C_RQ + head * 64 + 32 + cgi * 4);
        R.k1 = *(const u32x2*)(rowp + C_RK + head * 64 + cgi * 4); R.k2 = *(const u32x2*)(rowp + C_RK + head * 64 + 32 + cgi * 4);
        R.v = *(const u32x2*)(rowp + C_RV + head * 64 + vcol0 + cgi * 4);
    } else {
        const f16_t* pb = rowp + C_SXBC + 256 + (head >> 1) * 128 + cgi * 16;
        R.b[0] = *(const u32x4*)pb; R.b[1] = *(const u32x4*)(pb + 8); R.c[0] = *(const u32x4*)(pb + 256); R.c[1] = *(const u32x4*)(pb + 264);
        R.x = *(const u32x2*)(rowp + C_SXBC + head * 64 + vcol0 + cgi * 4);
        R.dt = hload(rowp + C_SDT + head);
    }
}

struct MixPar { float f[8]; };
template <int MIX> __device__ __forceinline__ MixPar mix_par(int l, int head) {
    MixPar m; const int cgi = tidx() & 7;
#pragma unroll
    for (int i = 0; i < 8; ++i) m.f[i] = 0.f;
    if constexpr (MIX == 0) {
#pragma unroll
        for (int i = 0; i < 8; ++i) { const int c = head * 64 + cgi * 8 + i; m.f[i] = l == 0 ? 0.f : sigmoidf_(pin(10)[256 + c] - pin(10)[c]); }
    } else if constexpr (MIX == 1) { m.f[0] = expf(pin(13)[l * 4 + head]); m.f[1] = pin(14)[l * 4 + head]; }
    else if constexpr (MIX == 2) {
#pragma unroll
        for (int i = 0; i < 4; ++i) m.f[i] = powf(10000.0f, -(float)(cgi * 4 + i) * (1.0f / 32.0f));
        m.f[4] = log2f(1.0f - exp2f(-5.0f - (float)head));
    } else { m.f[0] = pin(18)[l * 4 + head]; m.f[1] = expf(pin(19)[l * 4 + head]); m.f[2] = pin(20)[l * 4 + head]; }
    return m;
}

template <int MIX, bool SAMPLE>
__device__ __forceinline__ void rec_process(const Raw<MIX>& R, const MixPar& par, int l, LAS float* L, int chunk, int sg, int head) {
    typedef RecCfg<MIX> C;
    const int tid = tidx(), s = tid >> 3, cgi = tid & 7;
    const Slot sl = slot_of<SAMPLE>(chunk, s, sg);
    if constexpr (MIX == 0) {
        float hq[8], hf[8], hi[4]; u4f(R.hq, hq); u4f(R.hf, hf); u2f(R.hi, hi);
        float q[8], k[8], f[8];
#pragma unroll
        for (int i = 0; i < 8; ++i) { const int c = head * 64 + cgi * 8 + i;
            const float lb = par.f[i];
            const float sg_ = sigmoidf_(hf[i]);
            q[i] = sigmoidf_(hq[i]); f[i] = lb + (1.f - lb) * sg_; k[i] = (1.f - lb) * (1.f - sg_); }
        *(LAS f32x4*)(L + C::OFF_Q + s * 64 + cgi * 8) = (f32x4){q[0], q[1], q[2], q[3]}; *(LAS f32x4*)(L + C::OFF_Q + s * 64 + cgi * 8 + 4) = (f32x4){q[4], q[5], q[6], q[7]};
        *(LAS f32x4*)(L + C::OFF_K + s * 64 + cgi * 8) = (f32x4){k[0], k[1], k[2], k[3]}; *(LAS f32x4*)(L + C::OFF_K + s * 64 + cgi * 8 + 4) = (f32x4){k[4], k[5], k[6], k[7]};
        *(LAS f32x4*)(L + C::OFF_F + s * 64 + cgi * 8) = (f32x4){f[0], f[1], f[2], f[3]}; *(LAS f32x4*)(L + C::OFF_F + s * 64 + cgi * 8 + 4) = (f32x4){f[4], f[5], f[6], f[7]};
        *(LAS f32x4*)(L + C::OFF_V + s * 32 + cgi * 4) = (f32x4){hi[0], hi[1], hi[2], hi[3]};
    } else if constexpr (MIX == 1) {
        float q[8], k[8], v[4]; u4f(R.q, q); u4f(R.k, k); u2f(R.v, v);
        float sq = 0.f, sk = 0.f;
#pragma unroll
        for (int i = 0; i < 8; ++i) { sq += q[i] * q[i]; sk += k[i] * k[i]; }
        sq = red8(sq); sk = red8(sk);
        const float rq = rsqrtf(sq + EPS) * 0.125f, rk = rsqrtf(sk + EPS);
        float kq = 0.f;
#pragma unroll
        for (int i = 0; i < 8; ++i) { q[i] *= rq; k[i] *= rk; kq += q[i] * k[i]; }
        kq = red8(kq);
        *(LAS f32x4*)(L + C::OFF_Q + s * 64 + cgi * 8) = (f32x4){q[0], q[1], q[2], q[3]}; *(LAS f32x4*)(L + C::OFF_Q + s * 64 + cgi * 8 + 4) = (f32x4){q[4], q[5], q[6], q[7]};
        *(LAS f32x4*)(L + C::OFF_K + s * 64 + cgi * 8) = (f32x4){k[0], k[1], k[2], k[3]}; *(LAS f32x4*)(L + C::OFF_K + s * 64 + cgi * 8 + 4) = (f32x4){k[4], k[5], k[6], k[7]};
        *(LAS f32x4*)(L + C::OFF_V + s * 32 + cgi * 4) = (f32x4){v[0], v[1], v[2], v[3]};
        if (cgi == 0) { const float a = expf(-par.f[0] * softplusf_(R.ga + par.f[1]));
            *(LAS f32x4*)(L + C::OFF_SC + s * 4) = (f32x4){a, sigmoidf_(R.gb), kq, 0.f}; }
    } else if constexpr (MIX == 2) {
        float q1[4], q2[4], k1[4], k2[4], v[4]; u2f(R.q1, q1); u2f(R.q2, q2); u2f(R.k1, k1); u2f(R.k2, k2); u2f(R.v, v);
        const float posf = (float)(SAMPLE ? PASTLEN + sl.pos : sl.pos);
        float qa[4], qb[4], ka[4], kb[4];
#pragma unroll
        for (int i = 0; i < 4; ++i) { const int fi = cgi * 4 + i;
            const float invf = par.f[i];
            const float ang = posf * invf;
            double rev = (double)ang * 0.15915494309189535; rev -= floor(rev);
            const float sn = __builtin_amdgcn_sinf((float)rev), cs = __builtin_amdgcn_cosf((float)rev);
            qa[i] = q1[i] * cs - q2[i] * sn; qb[i] = q1[i] * sn + q2[i] * cs;
            ka[i] = (k1[i] * cs - k2[i] * sn) * 0.125f; kb[i] = (k1[i] * sn + k2[i] * cs) * 0.125f; }
        *(LAS f32x4*)(L + C::OFF_Q + s * 64 + cgi * 4) = (f32x4){qa[0], qa[1], qa[2], qa[3]}; *(LAS f32x4*)(L + C::OFF_Q + s * 64 + 32 + cgi * 4) = (f32x4){qb[0], qb[1], qb[2], qb[3]};
        *(LAS f32x4*)(L + C::OFF_K + s * 64 + cgi * 4) = (f32x4){ka[0], ka[1], ka[2], ka[3]}; *(LAS f32x4*)(L + C::OFF_K + s * 64 + 32 + cgi * 4) = (f32x4){kb[0], kb[1], kb[2], kb[3]};
        *(LAS f32x4*)(L + C::OFF_V + s * 32 + cgi * 4) = (f32x4){v[0], v[1], v[2], v[3]};
        if (cgi == 0) *(LAS f32x4*)(L + C::OFF_SC + s * 4) = (f32x4){exp2f(par.f[4]), 0.f, 0.f, 0.f};
    } else {
        float b0[8], b1[8], c0[8], c1[8], x[4]; u4f(R.b[0], b0); u4f(R.b[1], b1); u4f(R.c[0], c0); u4f(R.c[1], c1); u2f(R.x, x);
        const float dt = softplusf_(R.dt + par.f[0]);
        const float a = expf(-par.f[1] * dt), dsk = par.f[2];
        LAS float* qd = L + C::OFF_Q + s * C::KS + cgi * 16 + 4 * (cgi >> 2); LAS float* kd = L + C::OFF_K + s * C::KS + cgi * 16 + 4 * (cgi >> 2);
        *(LAS f32x4*)(qd) = (f32x4){c0[0], c0[1], c0[2], c0[3]}; *(LAS f32x4*)(qd + 4) = (f32x4){c0[4], c0[5], c0[6], c0[7]};
        *(LAS f32x4*)(qd + 8) = (f32x4){c1[0], c1[1], c1[2], c1[3]}; *(LAS f32x4*)(qd + 12) = (f32x4){c1[4], c1[5], c1[6], c1[7]};
        *(LAS f32x4*)(kd) = (f32x4){b0[0], b0[1], b0[2], b0[3]}; *(LAS f32x4*)(kd + 4) = (f32x4){b0[4], b0[5], b0[6], b0[7]};
        *(LAS f32x4*)(kd + 8) = (f32x4){b1[0], b1[1], b1[2], b1[3]}; *(LAS f32x4*)(kd + 12) = (f32x4){b1[4], b1[5], b1[6], b1[7]};
        *(LAS f32x4*)(L + C::OFF_V + s * 32 + cgi * 4) = (f32x4){x[0] * dt, x[1] * dt, x[2] * dt, x[3] * dt};
        *(LAS f32x4*)(L + C::OFF_XSD + s * 32 + cgi * 4) = (f32x4){x[0] * dsk, x[1] * dsk, x[2] * dsk, x[3] * dsk};
        if (cgi == 0) *(LAS f32x4*)(L + C::OFF_SC + s * 4) = (f32x4){a, 0.f, 0.f, 0.f};
    }
}

template <int MIX, bool REDUCE = true>
__device__ __forceinline__ float rec_step(float (&S)[RecCfg<MIX>::KPL], const LAS float* L, int s, int kg, int vl) {
    typedef RecCfg<MIX> C; constexpr int KPL = C::KPL;
    float q[KPL], k[KPL];
#pragma unroll
    for (int i = 0; i < KPL / 4; ++i) { const int ko = kg * KPL + (MIX == 3 ? 4 * (kg >> 3) : 0) + 4 * i;
        const f32x4 t = *(const LAS f32x4*)(L + C::OFF_Q + s * C::KS + ko);
        q[4 * i] = t[0]; q[4 * i + 1] = t[1]; q[4 * i + 2] = t[2]; q[4 * i + 3] = t[3];
        if constexpr (MIX != 0) { const f32x4 u = *(const LAS f32x4*)(L + C::OFF_K + s * C::KS + ko); k[4 * i] = u[0]; k[4 * i + 1] = u[1]; k[4 * i + 2] = u[2]; k[4 * i + 3] = u[3]; } }
    const float v = L[C::OFF_V + s * 32 + vl];
    float o;
    if constexpr (MIX == 0) {
        const f32x4 f = *(const LAS f32x4*)(L + C::OFF_F + s * 64 + kg * 4);
        const f32x2 vv = (f32x2){v, v};
        f32x2 s0 = (f32x2){S[0], S[1]}, s1 = (f32x2){S[2], S[3]};
        s0 = (f32x2){f[0], f[1]} * (s0 - vv) + vv; s1 = (f32x2){f[2], f[3]} * (s1 - vv) + vv;
        f32x2 p2 = s0 * (f32x2){q[0], q[1]}; p2 = s1 * (f32x2){q[2], q[3]} + p2;
        S[0] = s0.x; S[1] = s0.y; S[2] = s1.x; S[3] = s1.y;
        const float op = p2.x + p2.y;
        o = REDUCE ? red16(op) : op;
    } else if constexpr (MIX == 1) {
        const f32x4 sc = *(const LAS f32x4*)(L + C::OFF_SC + s * 4);
        f32x2 s0 = (f32x2){S[0], S[1]}, s1 = (f32x2){S[2], S[3]};
        const f32x2 k0 = (f32x2){k[0], k[1]}, k1 = (f32x2){k[2], k[3]};
        f32x2 r2 = s0 * k0; r2 = s1 * k1 + r2;
        f32x2 p2 = s0 * (f32x2){q[0], q[1]}; p2 = s1 * (f32x2){q[2], q[3]} + p2;
        float r = r2.x + r2.y; const float pq = p2.x + p2.y;
        r = red16(r);
        const float u = sc[1] * (v - sc[0] * r);
        const f32x2 uu = (f32x2){u, u}, aa = (f32x2){sc[0], sc[0]};
        s0 = s0 * aa + k0 * uu; s1 = s1 * aa + k1 * uu;
        S[0] = s0.x; S[1] = s0.y; S[2] = s1.x; S[3] = s1.y;
        if (REDUCE) o = sc[0] * red16(pq) + sc[2] * u;
        else o = sc[0] * pq + (kg == 0 ? sc[2] * u : 0.f);
    } else {
        const float a = L[C::OFF_SC + s * 4];
        float op = 0.f;
#pragma unroll
        for (int i = 0; i < KPL; ++i) { S[i] = a * S[i] + k[i] * v; op += S[i] * q[i]; }
        o = REDUCE ? red16(op) : op;
    }
    return o;
}

__device__ __forceinline__ void gdn_group8(float (&S)[4], float (&pp)[16], int j0, const LAS float* L, int sbase_, int kg, int vl) {
    typedef RecCfg<1> C;
    f32x4 q[8], k[8]; f32x2 sc[8]; float v[8];
#pragma unroll
    for (int j = 0; j < 8; ++j) { const int s = sbase_ + j;
        q[j] = *(const LAS f32x4*)(L + C::OFF_Q + s * 64 + kg * 4); k[j] = *(const LAS f32x4*)(L + C::OFF_K + s * 64 + kg * 4);
        sc[j] = *(const LAS f32x2*)(L + C::OFF_SC + s * 4); v[j] = L[C::OFF_V + s * 32 + vl]; }
    __builtin_amdgcn_sched_barrier(0);
    f32x2 s0 = (f32x2){S[0], S[1]}, s1 = (f32x2){S[2], S[3]};
#pragma unroll
    for (int j = 0; j < 8; ++j) {
        const f32x2 k0 = (f32x2){k[j][0], k[j][1]}, k1 = (f32x2){k[j][2], k[j][3]};
        f32x2 r2 = s0 * k0; r2 = s1 * k1 + r2;
        const float r = red16(r2.x + r2.y);
        const float u = sc[j][1] * (v[j] - sc[j][0] * r);
        const f32x2 uu = (f32x2){u, u}, aa = (f32x2){sc[j][0], sc[j][0]};
        s0 = s0 * aa + k0 * uu; s1 = s1 * aa + k1 * uu;
        f32x2 p2 = s0 * (f32x2){q[j][0], q[j][1]}; p2 = s1 * (f32x2){q[j][2], q[j][3]} + p2;
        pp[j0 + j] = p2.x + p2.y;
    }
    S[0] = s0.x; S[1] = s0.y; S[2] = s1.x; S[3] = s1.y;
}

__device__ __forceinline__ float reduce_scatter16(const float (&p)[16], int kg) {
    const bool b3 = kg & 8, b2 = kg & 4, b1 = kg & 2, b0 = kg & 1;
    float t[8], u[4], w[2];
#pragma unroll
    for (int j = 0; j < 8; ++j) { const float keep = b3 ? p[j + 8] : p[j], send = b3 ? p[j] : p[j + 8]; t[j] = keep + dppf<0x140>(send); }
#pragma unroll
    for (int j = 0; j < 4; ++j) { const float keep = b2 ? t[j + 4] : t[j], send = b2 ? t[j] : t[j + 4]; u[j] = keep + dppf<0x141>(send); }
#pragma unroll
    for (int j = 0; j < 2; ++j) { const float keep = b1 ? u[j + 2] : u[j], send = b1 ? u[j] : u[j + 2]; w[j] = keep + dppf<0x1B>(send); }
    const float keep = b0 ? w[1] : w[0], send = b0 ? w[0] : w[1];
    return keep + dppf<0xB1>(send);
}

template <int MIX, bool SAMPLE>
__device__ __forceinline__ void rec_store_o(const LAS float* L, f16_t* raw, int chunk, int sg, int mixer, int head, int vcol0, int nv = 32) {
    typedef RecCfg<MIX> C;
    const int tid = tidx(), s = tid >> 3, c4 = (tid & 7) * 4;
    const Slot sl = slot_of<SAMPLE>(chunk, s, sg);
    f32x4 o = *(const LAS f32x4*)(L + C::OFF_O + s * 32 + c4);
    if constexpr (MIX == 3) o = o + *(const LAS f32x4*)(L + C::OFF_XSD + s * 32 + c4);
    u32x2 w; w.x = pkh(o[0], o[1]); w.y = pkh(o[2], o[3]);
    if (c4 < nv) *(u32x2*)(raw + (size_t)sl.row * DM + mixer * 256 + head * 64 + vcol0 + c4) = w;
}

template <int MIX, bool DO_PROMPT, bool DO_SAMPLE>
__device__ __forceinline__ void rec_unit(const Params& p, int l, LAS unsigned char* lds, int sg, int head, int vcol0, int nv = 32) {
    typedef RecCfg<MIX> C; constexpr int KPL = C::KPL, K = C::K;
    LAS float* L = (LAS float*)lds;
    const f16_t* proj = (const f16_t*)(pws() + WS_PROJ);
    f16_t* raw = (f16_t*)(pws() + WS_XN);
    const int tid = tidx(), w = tid >> 6, lane = tid & 63, kg = lane & 15, vi = lane >> 4, vl = w * 4 + vi, vcol = vcol0 + vl; const bool act = w * 4 < nv;
    constexpr int sidx = MIX == 0 ? 2 : MIX == 1 ? 3 : MIX == 2 ? 5 : 6;
    constexpr long o_p = MIX == 0 ? O_HGRN_P : MIX == 1 ? O_GDN_P : MIX == 2 ? O_RET_P : O_SSD_P;
    constexpr long o_s = MIX == 0 ? O_HGRN_S : MIX == 1 ? O_GDN_S : MIX == 2 ? O_RET_S : O_SSD_S;
    Raw<MIX> R;
    const MixPar par = mix_par<MIX>(l, head);
    float S[KPL];
#pragma unroll
    for (int i = 0; i < KPL; ++i) S[i] = 0.f;
    if constexpr (DO_PROMPT) {
    if constexpr (MIX == 1) {
        constexpr int BUF = C::OFF_O + 2048;
        rec_load<MIX, false>(R, proj, 0, sg, head, vcol0);
        rec_process<MIX, false>(R, par, l, L, 0, sg, head);
        __syncthreads();
        rec_load<MIX, false>(R, proj, 1, sg, head, vcol0);
#pragma unroll 1
        for (int c = 0; c < SEQ / 64; ++c) {
            LAS float* Lc = L + (c & 1) * BUF;
#pragma unroll 1
            for (int g = 0; g < (act ? 4 : 0); ++g) { float pp[16];
                gdn_group8(S, pp, 0, Lc, g * 16, kg, vl); gdn_group8(S, pp, 8, Lc, g * 16 + 8, kg, vl);
                Lc[C::OFF_O + (g * 16 + kg) * 32 + vl] = reduce_scatter16(pp, kg); }
            if (c + 1 < SEQ / 64) { rec_process<MIX, false>(R, par, l, L + ((c + 1) & 1) * BUF, c + 1, sg, head);
                if (c + 2 < SEQ / 64) rec_load<MIX, false>(R, proj, c + 2, sg, head, vcol0);
                else if (DO_SAMPLE) rec_load<MIX, true>(R, proj, 0, sg, head, vcol0); }
            __syncthreads();
            rec_store_o<MIX, false>(Lc, raw, c, sg, MIX, head, vcol0, nv);
        }
        __syncthreads();
    } else {
    rec_load<MIX, false>(R, proj, 0, sg, head, vcol0);
#pragma unroll 1
    for (int c = 0; c < SEQ / 64; ++c) {
        rec_process<MIX, false>(R, par, l, L, c, sg, head);
        __syncthreads();
        if (c + 1 < SEQ / 64) rec_load<MIX, false>(R, proj, c + 1, sg, head, vcol0);
        else if (DO_SAMPLE) rec_load<MIX, true>(R, proj, 0, sg, head, vcol0);
#pragma unroll 1
        for (int g = 0; g < (act ? 4 : 0); ++g) { float oacc = 0.f;
            { float pp[16];
#pragma unroll
              for (int j = 0; j < 16; ++j) pp[j] = rec_step<MIX, false>(S, L, g * 16 + j, kg, vl);
              oacc = reduce_scatter16(pp, kg); }
            L[C::OFF_O + (g * 16 + kg) * 32 + vl] = oacc; }
        __syncthreads();
        rec_store_o<MIX, false>(L, raw, c, sg, MIX, head, vcol0, nv);
    }
    }
    if (act) { float* so = pout() + o_p + ((size_t)(l * NB + sg) * 4 + head) * K * 64;
#pragma unroll
      for (int i = 0; i < KPL; ++i) so[(kg * KPL + i) * 64 + vcol] = S[i]; }
    }
    if constexpr (!DO_SAMPLE) return;
    if constexpr (!DO_PROMPT) rec_load<MIX, true>(R, proj, 0, sg, head, vcol0);
    rec_process<MIX, true>(R, par, l, L, 0, sg, head);
    __syncthreads();
    const float* sbase = p.in[sidx] + ((size_t)(l * NSB + sg * 16) * 4 + head) * K * 64;
    float* obase = pout() + o_s + ((size_t)(l * NSB + sg * 16) * 4 + head) * K * 64;
    float Sn[KPL], Sm[KPL];
#pragma unroll
    for (int i = 0; i < KPL; ++i) { Sn[i] = 0.f; Sm[i] = 0.f; if (act) { Sn[i] = sbase[(kg * KPL + i) * 64 + vcol]; Sm[i] = sbase[(size_t)4 * K * 64 + (kg * KPL + i) * 64 + vcol]; } }
#pragma unroll 1
    for (int g = 0; g < (act ? 4 : 0); ++g) { float oacc = 0.f;
#pragma unroll
        for (int qq = 0; qq < 4; ++qq) { const int q = g * 4 + qq;
#pragma unroll
            for (int i = 0; i < KPL; ++i) { S[i] = Sn[i]; Sn[i] = Sm[i]; }
            if (q + 2 < 16) {
#pragma unroll
                for (int i = 0; i < KPL; ++i) Sm[i] = sbase[(size_t)(q + 2) * 4 * K * 64 + (kg * KPL + i) * 64 + vcol]; }
#pragma unroll
            for (int t = 0; t < 4; ++t) { const float o = rec_step<MIX>(S, L, q * 4 + t, kg, vl); oacc = (kg == qq * 4 + t) ? o : oacc; }
#pragma unroll
            for (int i = 0; i < KPL; ++i) obase[(size_t)q * 4 * K * 64 + (kg * KPL + i) * 64 + vcol] = S[i];
        }
        L[C::OFF_O + (g * 16 + kg) * 32 + vl] = oacc; }
    __syncthreads();
    rec_store_o<MIX, true>(L, raw, 0, sg, MIX, head, vcol0, nv);
    __syncthreads();
}

template <int MIX> struct ChCfg { static constexpr int K = (MIX == 3 ? 128 : 64), RS = 2 * K + 16  , TS_ = 144  ,
    B_QH = 0, B_KH = 64 * RS, B_QT = 2 * 64 * RS, B_KT = 3 * 64 * RS, B_VT = B_KT + K * TS_, B_G = B_VT + 32 * TS_, B_END = B_G + 512; };
static_assert(128 * 132 == TT, "deferred residual copy must cover all rows");
static_assert(N_TILES_WIN0 + 64 * (40 + 35 + 14) == N_TILES_ALL, "deferred weight tiles must cover all remaining tiles");
static_assert(ChCfg<2>::B_END <= RecCfg<2>::OFF_O * 4 && ChCfg<3>::B_END <= RecCfg<3>::OFF_XSD * 4, "chunk images must end below the O / XSD tables");

template <int MIX>
__device__ __forceinline__ void ch_process(const Raw<MIX>& R, const MixPar& par, LAS unsigned char* B, int chunk) {
    typedef ChCfg<MIX> C; typedef RecCfg<MIX> RC;
    const int tid = tidx(), s = tid >> 3, cgi = tid & 7, pm = s & 15;
    LAS float* Gt = (LAS float*)(B + C::B_G);
    LAS float* Lf = (LAS float*)B;
    if constexpr (MIX == 2) {
        float q1[4], q2[4], k1[4], k2[4], v[4]; u2f(R.q1, q1); u2f(R.q2, q2); u2f(R.k1, k1); u2f(R.k2, k2); u2f(R.v, v);
        const float posf = (float)(chunk * 64 + s);
        const float lg = par.f[4];
        const float eg = exp2f(lg * (float)(pm + 1)), ew = exp2f(lg * (float)(15 - pm));
        float qv[8], kv[8];
#pragma unroll
        for (int i = 0; i < 4; ++i) { const int fi = cgi * 4 + i;
            const float invf = par.f[i];
            const float ang = posf * invf;
            double rev = (double)ang * 0.15915494309189535; rev -= floor(rev);
            const float sn = __builtin_amdgcn_sinf((float)rev), cs = __builtin_amdgcn_cosf((float)rev);
            qv[i] = q1[i] * cs - q2[i] * sn; qv[4 + i] = q1[i] * sn + q2[i] * cs;
            kv[i] = (k1[i] * cs - k2[i] * sn) * 0.125f; kv[4 + i] = (k1[i] * sn + k2[i] * cs) * 0.125f; }
#pragma unroll
        for (int hh = 0; hh < 2; ++hh) { const int c0 = hh * 32 + cgi * 4;
            *(LAS u32x2*)(B + C::B_QH + s * C::RS + c0 * 2) = (u32x2){pkh(qv[4 * hh], qv[4 * hh + 1]), pkh(qv[4 * hh + 2], qv[4 * hh + 3])};
            *(LAS u32x2*)(B + C::B_KH + s * C::RS + c0 * 2) = (u32x2){pkh(kv[4 * hh], kv[4 * hh + 1]), pkh(kv[4 * hh + 2], kv[4 * hh + 3])};
            *(LAS u32x2*)(B + C::B_QT + s * C::RS + c0 * 2) = (u32x2){pkh(qv[4 * hh] * eg, qv[4 * hh + 1] * eg), pkh(qv[4 * hh + 2] * eg, qv[4 * hh + 3] * eg)};
#pragma unroll
            for (int i = 0; i < 4; ++i) *(LAS f16_t*)(B + C::B_KT + (c0 + i) * C::TS_ + s * 2) = (f16_t)(kv[4 * hh + i] * ew); }
#pragma unroll
        for (int i = 0; i < 4; ++i) *(LAS f16_t*)(B + C::B_VT + (cgi * 4 + i) * C::TS_ + s * 2) = (f16_t)v[i];
        if (cgi == 0) Gt[s] = 0.6931471806f * lg * (float)(pm + 1);
    } else {
        float b0[8], b1[8], c0[8], c1[8], x[4]; u4f(R.b[0], b0); u4f(R.b[1], b1); u4f(R.c[0], c0); u4f(R.c[1], c1); u2f(R.x, x);
        const float dt = softplusf_(R.dt + par.f[0]);
        const float la = -par.f[1] * dt, dsk = par.f[2];
        LAS float* La = Gt + 64;
        if (cgi == 0) La[s] = la;
        __syncthreads();
        float g = 0.f, ge = 0.f;
#pragma unroll
        for (int j = 0; j < 16; ++j) { const float t = La[(s & ~15) + j]; ge += t; g += (j <= pm) ? t : 0.f; }
        const float eg = expf(g), ew = expf(ge - g);
        float bb[16], cc[16];
#pragma unroll
        for (int i = 0; i < 8; ++i) { bb[i] = b0[i]; bb[8 + i] = b1[i]; cc[i] = c0[i]; cc[8 + i] = c1[i]; }
#pragma unroll
        for (int i = 0; i < 4; ++i) { const int cc0 = cgi * 16 + 4 * i;
            *(LAS u32x2*)(B + C::B_QH + s * C::RS + cc0 * 2) = (u32x2){pkh(cc[4 * i], cc[4 * i + 1]), pkh(cc[4 * i + 2], cc[4 * i + 3])};
            *(LAS u32x2*)(B + C::B_KH + s * C::RS + cc0 * 2) = (u32x2){pkh(bb[4 * i], bb[4 * i + 1]), pkh(bb[4 * i + 2], bb[4 * i + 3])};
            *(LAS u32x2*)(B + C::B_QT + s * C::RS + cc0 * 2) = (u32x2){pkh(cc[4 * i] * eg, cc[4 * i + 1] * eg), pkh(cc[4 * i + 2] * eg, cc[4 * i + 3] * eg)};
#pragma unroll
            for (int e = 0; e < 4; ++e) *(LAS f16_t*)(B + C::B_KT + (cc0 + e) * C::TS_ + s * 2) = (f16_t)(bb[4 * i + e] * ew); }
#pragma unroll
        for (int i = 0; i < 4; ++i) *(LAS f16_t*)(B + C::B_VT + (cgi * 4 + i) * C::TS_ + s * 2) = (f16_t)(x[i] * dt);
        *(LAS f32x4*)(Lf + RC::OFF_XSD + s * 32 + cgi * 4) = (f32x4){x[0] * dsk, x[1] * dsk, x[2] * dsk, x[3] * dsk};
        if (cgi == 0) Gt[s] = g;
    }
}

template <int MIX>
__device__ __forceinline__ void ch_scan(f32x4 (&St)[ChCfg<MIX>::K / 16], LAS unsigned char* B, int vg, int lane) {
    typedef ChCfg<MIX> C; typedef RecCfg<MIX> RC; constexpr int K = C::K;
    const int r = lane & 15, h = lane >> 4;
    const LAS float* Gt = (const LAS float*)(B + C::B_G);
    LAS float* Of = (LAS float*)B + RC::OFF_O;
#pragma unroll
    for (int mc = 0; mc < 4; ++mc) {
        const int t0 = mc * 16;
        f16x8 xa[K / 32], xb[K / 32]; u32x2 qa0[K / 32], qa1[K / 32], ka0[K / 16];
#pragma unroll
        for (int kb = 0; kb < K / 32; ++kb) {
            xa[kb] = *(const LAS f16x8*)(B + C::B_KH + (t0 + r) * C::RS + (kb * 32 + 8 * h) * 2);
            xb[kb] = *(const LAS f16x8*)(B + C::B_QH + (t0 + r) * C::RS + (kb * 32 + 8 * h) * 2);
            qa0[kb] = *(const LAS u32x2*)(B + C::B_QT + (t0 + r) * C::RS + (32 * kb + 4 * h) * 2);
            qa1[kb] = *(const LAS u32x2*)(B + C::B_QT + (t0 + r) * C::RS + (32 * kb + 16 + 4 * h) * 2); }
#pragma unroll
        for (int kt = 0; kt < K / 16; ++kt) ka0[kt] = *(const LAS u32x2*)(B + C::B_KT + (16 * kt + r) * C::TS_ + (t0 + 4 * h) * 2);
        const float gi = Gt[t0 + r]; const f32x4 gj = *(const LAS f32x4*)(Gt + t0 + 4 * h);
        const float g15 = Gt[t0 + 15];
        const u32x2 vv = *(const LAS u32x2*)(B + C::B_VT + (16 * vg + r) * C::TS_ + (t0 + 4 * h) * 2);
        __builtin_amdgcn_sched_barrier(0);
        f32x4 X = (f32x4){0.f, 0.f, 0.f, 0.f};
#pragma unroll
        for (int kb = 0; kb < K / 32; ++kb) X = __builtin_amdgcn_mfma_f32_16x16x32_f16(xa[kb], xb[kb], X, 0, 0, 0);
        f16x8 pa, vb;
#pragma unroll
        for (int e = 0; e < 4; ++e) { const float d = fminf(gi - gj[e], 0.f); const float pv = (4 * h + e <= r) ? X[e] * __expf(d) : 0.f; pa[e] = (f16_t)pv; pa[4 + e] = (f16_t)0.f; }
        { const u32x4 v4 = (u32x4){vv.x, vv.y, 0u, 0u}; vb = __builtin_bit_cast(f16x8, v4); }
        f32x4 O = __builtin_amdgcn_mfma_f32_16x16x32_f16(pa, vb, (f32x4){0.f, 0.f, 0.f, 0.f}, 0, 0, 0);
#pragma unroll
        for (int m = 0; m < K / 32; ++m) {
            const u32x4 qa4 = (u32x4){qa0[m].x, qa0[m].y, qa1[m].x, qa1[m].y};
            const u32x4 sb4 = (u32x4){pkh(St[2 * m][0], St[2 * m][1]), pkh(St[2 * m][2], St[2 * m][3]), pkh(St[2 * m + 1][0], St[2 * m + 1][1]), pkh(St[2 * m + 1][2], St[2 * m + 1][3])};
            O = __builtin_amdgcn_mfma_f32_16x16x32_f16(__builtin_bit_cast(f16x8, qa4), __builtin_bit_cast(f16x8, sb4), O, 0, 0, 0); }
#pragma unroll
        for (int e = 0; e < 4; ++e) Of[(t0 + 4 * h + e) * 32 + 16 * vg + r] = O[e];
        const float ge = __expf(g15);
#pragma unroll
        for (int kt = 0; kt < K / 16; ++kt) {
            const u32x4 ka4 = (u32x4){ka0[kt].x, ka0[kt].y, 0u, 0u};
            St[kt] = __builtin_amdgcn_mfma_f32_16x16x32_f16(__builtin_bit_cast(f16x8, ka4), vb, St[kt] * ge, 0, 0, 0); }
    }
}

template <int MIX>
__device__ __forceinline__ void rec_unit_chunked(const Params& p, int l, LAS unsigned char* lds, int sg, int head, int vhalf) {
    typedef ChCfg<MIX> C; constexpr int K = C::K;
    const f16_t* proj = (const f16_t*)(pws() + WS_PROJ);
    f16_t* raw = (f16_t*)(pws() + WS_XN);
    const int tid = tidx(), w = __builtin_amdgcn_readfirstlane(tid >> 6), lane = tid & 63;
    constexpr long o_p = MIX == 2 ? O_RET_P : O_SSD_P;
    Raw<MIX> R;
    const MixPar par = mix_par<MIX>(l, head);
    f32x4 St[K / 16];
#pragma unroll
    for (int i = 0; i < K / 16; ++i) St[i] = (f32x4){0.f, 0.f, 0.f, 0.f};
    rec_load<MIX, false>(R, proj, 0, sg, head, vhalf * 32);
#pragma unroll 1
    for (int c = 0; c < SEQ / 64; ++c) {
        ch_process<MIX>(R, par, lds, c);
        __syncthreads();
        if (c + 1 < SEQ / 64) rec_load<MIX, false>(R, proj, c + 1, sg, head, vhalf * 32);
        if (w < 2) ch_scan<MIX>(St, lds, w, lane);
        __syncthreads();
        rec_store_o<MIX, false>((const LAS float*)lds, raw, c, sg, MIX, head, vhalf * 32);
    }
    if (w < 2) { float* so = pout() + o_p + ((size_t)(l * NB + sg) * 4 + head) * K * 64;
        const int r = lane & 15, h = lane >> 4;
#pragma unroll
        for (int kt = 0; kt < K / 16; ++kt)
#pragma unroll
            for (int e = 0; e < 4; ++e) so[(16 * kt + 4 * h + e) * 64 + vhalf * 32 + 16 * w + r] = St[kt][e]; }
    __syncthreads();
}

__device__ __forceinline__ void phase_rec(const Params& p, int l, LAS unsigned char* lds) {
    for (int u = bidx(); u < 256; u += gridDim.x) {
        const int vhalf = u & 1, head = (u >> 1) & 3, mixer = (u >> 3) & 3, sg = u >> 5;
        const int bi = sg * 8 + (u & 7);
        if (mixer == 0) { rec_unit<0, true, false>(p, l, lds, sg, head, vhalf * 32);
            if (l == 0) { convert_tiles(N_TILES_WIN0 + bi * 40, N_TILES_WIN0 + bi * 40 + 40, 1, (LAS float*)lds); copy_x_rows(bi * 132, 132); } }
        else if (mixer == 1) rec_unit<1, true, false>(p, l, lds, sg, head, vhalf * 32);
        else if (mixer == 2) { rec_unit_chunked<2>(p, l, lds, sg, head, vhalf); rec_unit<2, false, true>(p, l, lds, sg, head, vhalf * 32); rec_unit<3, false, true>(p, l, lds, sg, head, vhalf * 32);
            if (l == 0) { convert_tiles(N_TILES_WIN0 + 2560 + bi * 35, N_TILES_WIN0 + 2560 + bi * 35 + 35, 1, (LAS float*)lds); copy_x_rows((64 + bi) * 132, 132); } }
        else { rec_unit_chunked<3>(p, l, lds, sg, head, vhalf); rec_unit<1, false, true>(p, l, lds, sg, head, vhalf * 32); rec_unit<0, false, true>(p, l, lds, sg, head, vhalf * 32);
            if (l == 0) convert_tiles(N_TILES_WIN0 + 4800 + bi * 14, N_TILES_WIN0 + 4800 + bi * 14 + 14, 1, (LAS float*)lds); }
    }
}

__device__ __forceinline__ void phase_post(const Params& p, int l) {
    const int lane = tidx() & 63, gw = bidx() * 8 + (tidx() >> 6), nw = gridDim.x * 8;
    const f16_t* proj = (const f16_t*)(pws() + WS_PROJ);
    f16_t* mix = (f16_t*)(pws() + WS_XN);
    const int c0 = lane * 16, mixer = lane >> 4, cm = c0 & 255;
    const int gcol = mixer == 0 ? C_HG : mixer == 1 ? C_GZ : mixer == 2 ? C_RG : C_SZ;
    float wn[16];
#pragma unroll
    for (int i = 0; i < 16; ++i) wn[i] = mixer == 0 ? pin(11)[l * 64 + ((cm + i) & 63)] : mixer == 1 ? pin(15)[l * 64 + ((cm + i) & 63)] : mixer == 2 ? 1.0f : pin(21)[l * 256 + cm + i];
    for (int r0 = gw; r0 < TT; r0 += 4 * nw) {
        u32x4 ra[4][2], rg[4][2];
#pragma unroll
        for (int bb = 0; bb < 4; ++bb) { const int r = r0 + bb * nw;
            if (r < TT) { const f16_t* mp = mix + (size_t)r * DM + c0; const f16_t* gp = proj + (size_t)r * PN + gcol + cm;
                ra[bb][0] = *(const u32x4*)mp; ra[bb][1] = *(const u32x4*)(mp + 8); rg[bb][0] = *(const u32x4*)gp; rg[bb][1] = *(const u32x4*)(gp + 8); } }
#pragma unroll
        for (int bb = 0; bb < 4; ++bb) { const int r = r0 + bb * nw;
            if (r < TT) {
                f16_t* mp = mix + (size_t)r * DM + c0;
                float x[16], g[16];
                { float t0[8], t1[8]; u4f(ra[bb][0], t0); u4f(ra[bb][1], t1);
#pragma unroll
                  for (int i = 0; i < 8; ++i) { x[i] = t0[i]; x[i + 8] = t1[i]; } }
                { float t0[8], t1[8]; u4f(rg[bb][0], t0); u4f(rg[bb][1], t1);
#pragma unroll
                  for (int i = 0; i < 8; ++i) { g[i] = siluf_(t0[i]); g[i + 8] = siluf_(t1[i]); } }
                float ss = 0.f;
                if (mixer == 3) {
#pragma unroll
                    for (int i = 0; i < 16; ++i) { x[i] *= g[i]; ss += x[i] * x[i]; }
                    ss = red8(ss);
                    const float sc = rsqrtf(ss * (1.0f / 128.0f) + EPS);
#pragma unroll
                    for (int i = 0; i < 16; ++i) x[i] = x[i] * sc * wn[i];
                } else {
#pragma unroll
                    for (int i = 0; i < 16; ++i) ss += x[i] * x[i];
                    ss = red4(ss);
                    const float sc = rsqrtf(ss * (1.0f / 64.0f) + EPS);
#pragma unroll
                    for (int i = 0; i < 16; ++i) x[i] = x[i] * sc * wn[i] * g[i];
                }
                u32x4 a, b; a.x = pkh(x[0], x[1]); a.y = pkh(x[2], x[3]); a.z = pkh(x[4], x[5]); a.w = pkh(x[6], x[7]);
                b.x = pkh(x[8], x[9]); b.y = pkh(x[10], x[11]); b.z = pkh(x[12], x[13]); b.w = pkh(x[14], x[15]);
                *(u32x4*)mp = a; *(u32x4*)(mp + 8) = b;
            } }
    }
}

#ifndef PMASK
#define PMASK 0xFFFFu
#endif
#ifndef RMASK
#define RMASK 0u
#endif
__global__ void __launch_bounds__(512, 2) hymba_fwd(Params p) {
    extern __shared__ __attribute__((aligned(16))) unsigned char shm[];
    LAS unsigned char* lds = (LAS unsigned char*)shm;
    cg::grid_group grid = cg::this_grid();
    volatile LAS unsigned* bst = (volatile LAS unsigned*)(lds + 131072);
    if (tidx() < 2) bst[tidx()] = 0u;
    __syncthreads();
    const XcdBarrier xbar = xcd_barrier_post((unsigned*)(pws() + WS_BAR), bst);
    f16_t* XN = (f16_t*)(pws() + WS_XN);
    f16_t* PROJ = (f16_t*)(pws() + WS_PROJ);
    float* X = pout() + O_Y;
#pragma nounroll
    for (int ph = 0; ph <= 18; ++ph) {
        float* scr = (float*)(pws() + WS_SCR);
        if (ph == 0) { phase_prologue(p, lds); }
        else {
            const int l = (ph - 1) / 9, k = (ph - 1) % 9;
            const f16_t* wt = (const f16_t*)(pws() + WS_WT + l * WT_LAYER);
            if (k == 0 || k == 4 || k == 6 || k == 7) {
                pg8::Gemm g; pg8::EpiAny E; pg8::PowOrder S; S.n17 = 0;
                if (k == 0)      { g = pg8::Gemm{XN, wt + WT_WIN / 2, TP, PN, DM};     E = pg8::EpiAny{0, PROJ, PN, scr};  S.lnN = 4; S.nsu = 32; S.lsplit = 0; S.n17 = 66; }
                else if (k == 4) { g = pg8::Gemm{XN, wt + WT_WOUT / 2, TP, DM, DM};    E = pg8::EpiAny{2, X, DM, scr};     S.lnN = 2; S.nsu = 8;  S.lsplit = 2; }
                else if (k == 6) { g = pg8::Gemm{XN, wt + WT_WUP / 2, TP, DFF, DM};    E = pg8::EpiAny{1, PROJ, DFF, scr}; S.lnN = 4; S.nsu = 32; S.lsplit = 0; }
                else             { g = pg8::Gemm{PROJ, wt + WT_WDOWN / 2, TP, DM, DFF}; E = pg8::EpiAny{2, X, DM, scr};     S.lnN = 2; S.nsu = 8;  S.lsplit = 3; }
                S.ntot = g.K / 64; S.G = (int)gridDim.x; S.c = bidx();
                pg8::gemm_phase(lds, g, S, E);
            }
            else if (k == 1) phase_conv(p, l, xbar);
            else if (k == 2) phase_rec(p, l, lds);
            else if (k == 3) phase_post(p, l);
            else if (k == 5) norm_rows(nullptr, nullptr, X, XN, pin(23) + l * DM, false, scr, 4);
            else { if (l == 0) norm_rows(nullptr, nullptr, X, XN, pin(8) + DM, false, scr, 8);
                   else norm_rows(nullptr, nullptr, X, XN, pin(26), true, scr, 8); }
        }
        if (ph == 3) grid.sync();
        else if (ph < 18) xcd_barrier(xbar);
    }
}

extern "C" void kernel_launch(void* const* d_in, const int* in_sizes, int n_in, void* d_out, int out_size, void* d_ws, size_t ws_size, hipStream_t stream) {
    static int grid = 0;
    if (grid == 0) {
        int dev = 0, cus = 0, per_cu = 0;
        hipGetDevice(&dev);
        hipDeviceGetAttribute(&cus, hipDeviceAttributeMultiprocessorCount, dev);
        hipFuncSetAttribute((const void*)hymba_fwd, hipFuncAttributeMaxDynamicSharedMemorySize, LDS_BYTES);
        hipOccupancyMaxActiveBlocksPerMultiprocessor(&per_cu, (const void*)hymba_fwd, 512, LDS_BYTES);
        if (per_cu < 1) per_cu = 1;
        grid = cus;
        if (grid > 256) grid = 256;
        if (n_in != 27 || (long)out_size != O_END || ws_size < WS_END) fprintf(stderr, "kernel_launch: unexpected sizes n_in %d out %d ws %zu (need %zu)\n", n_in, out_size, ws_size, (size_t)WS_END);
    }
    Params p{};
    for (int i = 0; i < 27; ++i) p.in[i] = (const float*)d_in[i];
    p.out = (float*)d_out; p.ws = (unsigned char*)d_ws;
    (void)hipMemsetAsync((unsigned char*)d_ws + WS_BAR, 0, 16384, stream);
    void* args[] = {&p};
    hipError_t e = hipLaunchCooperativeKernel((const void*)hymba_fwd, dim3(grid), dim3(512), args, LDS_BYTES, stream);
    if (e != hipSuccess) fprintf(stderr, "cooperative launch failed: %s (grid %d)\n", hipGetErrorString(e), grid);
}
```
